# Optimizing an MI355X kernel written in HIP

```python
import math
import jax, jax.numpy as jnp
from jax import lax
import numpy as np

D_MODEL = 2048
BATCH = 8
SEQ = 2048
DEPTH = 1

CHUNK = 64
HEAD_DIM = 128
ATTN_WIDTH = D_MODEL // 2
ATTN_HEADS = ATTN_WIDTH // HEAD_DIM
SSM_WIDTH = D_MODEL - ATTN_WIDTH
SSM_GROUP = 16
SSM_GROUPS = SSM_WIDTH // SSM_GROUP
SSM_STATE = 64
IN_WIDTH = 3 * ATTN_WIDTH + SSM_WIDTH
N_BACK_CHUNKS = 8
BAND = (N_BACK_CHUNKS + 1) * CHUNK
REL_CLIP = 128
N_REL = 2 * REL_CLIP + 1
N_EXPERTS = 32
TOP_K = 4
D_FF = D_MODEL
SWIGLU_LIMIT = 7.0
SWIGLU_ALPHA = 1.702
DT_MIN = 0.001
DT_MAX = 0.1
EPS = 1e-5

kernel_name = "hybrid_s5_chunkattn_moe_block"


def _rmsnorm(x, g):
    xf = x.astype(jnp.float32)
    r = lax.rsqrt(jnp.mean(xf * xf, axis=-1, keepdims=True) + EPS)
    return (xf * r * g.astype(jnp.float32)).astype(x.dtype)


def _chunk_attention(q, k, v, rel_bias):
    bsz, L, _ = q.shape
    nc = L // CHUNK
    q = q.reshape(bsz, nc, CHUNK, ATTN_HEADS, HEAD_DIM)
    k = k.reshape(bsz, nc, CHUNK, ATTN_HEADS, HEAD_DIM)
    v = v.reshape(bsz, nc, CHUNK, ATTN_HEADS, HEAD_DIM)
    pad = ((0, 0), (N_BACK_CHUNKS, 0), (0, 0), (0, 0), (0, 0))
    kp = jnp.pad(k, pad)
    vp = jnp.pad(v, pad)
    band_idx = jnp.arange(nc)[:, None] + jnp.arange(N_BACK_CHUNKS + 1)[None, :]
    kb = kp[:, band_idx].reshape(bsz, nc, BAND, ATTN_HEADS, HEAD_DIM)
    vb = vp[:, band_idx].reshape(bsz, nc, BAND, ATTN_HEADS, HEAD_DIM)
    valid = jnp.repeat(band_idx >= N_BACK_CHUNKS, CHUNK, axis=1)
    rel = N_BACK_CHUNKS * CHUNK + jnp.arange(CHUNK)[:, None] - jnp.arange(BAND)[None, :]
    rel_idx = jnp.clip(rel, -REL_CLIP, REL_CLIP) + REL_CLIP
    bias = rel_bias.astype(jnp.float32)[:, rel_idx]
    scale = 1.0 / math.sqrt(HEAD_DIM)
    s = jnp.einsum('bnqhd,bnkhd->bhnqk', q, kb, preferred_element_type=jnp.float32) * scale
    s = s + bias[None, :, None]
    s = jnp.where(valid[None, None, :, None, :], s, jnp.float32(-1e30))
    p = jax.nn.softmax(s, axis=-1)
    o = jnp.einsum('bhnqk,bnkhd->bnqhd', p.astype(v.dtype), vb)
    return o.reshape(bsz, L, ATTN_WIDTH)


def _s5(u, lam_re, lam_im, log_step, b_re, b_im, c_re, c_im, d, w_glu, b_glu):
    f32 = jnp.float32
    bsz, L, _ = u.shape
    uf = u.astype(f32)
    ug = uf.reshape(bsz, L, SSM_GROUPS, SSM_GROUP)
    dt = jnp.exp(log_step.astype(f32))[:, None]
    lr = lam_re.astype(f32)
    li = lam_im.astype(f32)
    mag = jnp.exp(lr * dt)
    ab_re = mag * jnp.cos(li * dt)
    ab_im = mag * jnp.sin(li * dt)
    den = lr * lr + li * li
    nr = ab_re - 1.0
    ni = ab_im
    f_re = (nr * lr + ni * li) / den
    f_im = (ni * lr - nr * li) / den
    br = b_re.astype(f32)
    bi = b_im.astype(f32)
    bb_re = f_re[..., None] * br - f_im[..., None] * bi
    bb_im = f_re[..., None] * bi + f_im[..., None] * br
    x_re = jnp.einsum('blgc,gpc->blgp', ug, bb_re)
    x_im = jnp.einsum('blgc,gpc->blgp', ug, bb_im)
    a_re = jnp.broadcast_to(ab_re, (1, L, SSM_GROUPS, SSM_STATE))
    a_im = jnp.broadcast_to(ab_im, (1, L, SSM_GROUPS, SSM_STATE))

    def combine(e1, e2):
        a1r, a1i, b1r, b1i = e1
        a2r, a2i, b2r, b2i = e2
        return (a2r * a1r - a2i * a1i,
                a2r * a1i + a2i * a1r,
                a2r * b1r - a2i * b1i + b2r,
                a2r * b1i + a2i * b1r + b2i)

    _, _, h_re, h_im = lax.associative_scan(combine, (a_re, a_im, x_re, x_im), axis=1)
    y = (jnp.einsum('blgp,gcp->blgc', h_re, c_re.astype(f32))
         - jnp.einsum('blgp,gcp->blgc', h_im, c_im.astype(f32)))
    y = y.reshape(bsz, L, SSM_WIDTH) + d.astype(f32) * uf
    y = jax.nn.gelu(y)
    y = y * jax.nn.sigmoid(y @ w_glu.astype(f32) + b_glu.astype(f32))
    return y.astype(u.dtype)


def _moe(xn, w_router, b_router, w_gate, b_gate, w_up, b_up, w_down, b_down):
    bsz, L, D = xn.shape
    t = xn.reshape(-1, D)
    logits = (t @ w_router).astype(jnp.float32) + b_router.astype(jnp.float32)
    top_vals, top_idx = lax.top_k(logits, TOP_K)
    gates = jax.nn.softmax(top_vals, axis=-1)
    comb = jnp.sum(jax.nn.one_hot(top_idx, N_EXPERTS, dtype=jnp.float32) * gates[..., None], axis=1)
    out = jnp.zeros((t.shape[0], D), jnp.float32)
    for e in range(N_EXPERTS):
        g = jnp.minimum(t @ w_gate[e] + b_gate[e], SWIGLU_LIMIT)
        u = jnp.clip(t @ w_up[e] + b_up[e], -SWIGLU_LIMIT, SWIGLU_LIMIT)
        hdn = g * jax.nn.sigmoid(SWIGLU_ALPHA * g) * (u + 1.0)
        y = hdn @ w_down[e] + b_down[e]
        out = out + comb[:, e:e + 1] * y.astype(jnp.float32)
    return out.astype(xn.dtype).reshape(bsz, L, D)


def setup_inputs(seed: int = 0) -> dict:
    key = jax.random.key(seed)
    ks = jax.random.split(key, 32)
    f32 = jnp.float32
    nrm = lambda k, shp, s: jax.random.normal(k, shp, f32) * s
    lam_im_base = jnp.pi * jnp.arange(SSM_STATE, dtype=f32)
    return {
        "x": nrm(ks[0], (BATCH, SEQ, D_MODEL), 1.0),
        "norm1_g": 1.0 + nrm(ks[1], (DEPTH, D_MODEL), 0.01),
        "w_in": nrm(ks[2], (DEPTH, D_MODEL, IN_WIDTH), D_MODEL ** -0.5),
        "rel_bias": nrm(ks[3], (DEPTH, ATTN_HEADS, N_REL), 0.1),
        "ssm_lambda_re": -0.5 + nrm(ks[4], (DEPTH, SSM_GROUPS, SSM_STATE), 0.01),
        "ssm_lambda_im": lam_im_base + nrm(ks[5], (DEPTH, SSM_GROUPS, SSM_STATE), 0.01),
        "ssm_log_step": jax.random.uniform(ks[6], (DEPTH, SSM_GROUPS), f32, math.log(DT_MIN), math.log(DT_MAX)),
        "ssm_b_re": nrm(ks[7], (DEPTH, SSM_GROUPS, SSM_STATE, SSM_GROUP), (2 * SSM_GROUP) ** -0.5),
        "ssm_b_im": nrm(ks[8], (DEPTH, SSM_GROUPS, SSM_STATE, SSM_GROUP), (2 * SSM_GROUP) ** -0.5),
        "ssm_c_re": nrm(ks[9], (DEPTH, SSM_GROUPS, SSM_GROUP, SSM_STATE), (2 * SSM_STATE) ** -0.5),
        "ssm_c_im": nrm(ks[10], (DEPTH, SSM_GROUPS, SSM_GROUP, SSM_STATE), (2 * SSM_STATE) ** -0.5),
        "ssm_d": nrm(ks[11], (DEPTH, SSM_WIDTH), 1.0),
        "w_ssm_glu": nrm(ks[12], (DEPTH, SSM_WIDTH, SSM_WIDTH), SSM_WIDTH ** -0.5),
        "b_ssm_glu": nrm(ks[13], (DEPTH, SSM_WIDTH), 0.01),
        "attn_out_g": 1.0 + nrm(ks[14], (DEPTH, ATTN_WIDTH), 0.01),
        "ssm_out_g": 1.0 + nrm(ks[15], (DEPTH, SSM_WIDTH), 0.01),
        "w_out": nrm(ks[16], (DEPTH, D_MODEL, D_MODEL), D_MODEL ** -0.5),
        "norm2_g": 1.0 + nrm(ks[17], (DEPTH, D_MODEL), 0.01),
        "w_router": nrm(ks[18], (DEPTH, D_MODEL, N_EXPERTS), D_MODEL ** -0.5),
        "b_router": nrm(ks[19], (DEPTH, N_EXPERTS), 0.01),
        "w_gate": nrm(ks[20], (DEPTH, N_EXPERTS, D_MODEL, D_FF), D_MODEL ** -0.5),
        "b_gate": nrm(ks[21], (DEPTH, N_EXPERTS, D_FF), 0.01),
        "w_up": nrm(ks[22], (DEPTH, N_EXPERTS, D_MODEL, D_FF), D_MODEL ** -0.5),
        "b_up": nrm(ks[23], (DEPTH, N_EXPERTS, D_FF), 0.01),
        "w_down": nrm(ks[24], (DEPTH, N_EXPERTS, D_FF, D_MODEL), D_FF ** -0.5),
        "b_down": nrm(ks[25], (DEPTH, N_EXPERTS, D_MODEL), 0.01),
        "norm_f_g": 1.0 + nrm(ks[26], (D_MODEL,), 0.01),
    }


def reference(x, norm1_g, w_in, rel_bias, ssm_lambda_re, ssm_lambda_im, ssm_log_step,
              ssm_b_re, ssm_b_im, ssm_c_re, ssm_c_im, ssm_d, w_ssm_glu, b_ssm_glu,
              attn_out_g, ssm_out_g, w_out, norm2_g, w_router, b_router,
              w_gate, b_gate, w_up, b_up, w_down, b_down, norm_f_g):
    h = x
    for l in range(DEPTH):
        n = _rmsnorm(h, norm1_g[l])
        proj = n @ w_in[l]
        q = proj[..., :ATTN_WIDTH]
        k = proj[..., ATTN_WIDTH:2 * ATTN_WIDTH]
        v = proj[..., 2 * ATTN_WIDTH:3 * ATTN_WIDTH]
        u = proj[..., 3 * ATTN_WIDTH:]
        a_out = _chunk_attention(q, k, v, rel_bias[l])
        s_out = _s5(u, ssm_lambda_re[l], ssm_lambda_im[l], ssm_log_step[l],
                    ssm_b_re[l], ssm_b_im[l], ssm_c_re[l], ssm_c_im[l], ssm_d[l],
                    w_ssm_glu[l], b_ssm_glu[l])
        mixed = jnp.concatenate([_rmsnorm(a_out, attn_out_g[l]),
                                 _rmsnorm(s_out, ssm_out_g[l])], axis=-1)
        h = h + mixed @ w_out[l]
        n2 = _rmsnorm(h, norm2_g[l])
        h = h + _moe(n2, w_router[l], b_router[l], w_gate[l], b_gate[l],
                     w_up[l], b_up[l], w_down[l], b_down[l])
    return _rmsnorm(h, norm_f_g)
```

```cpp
#include <hip/hip_runtime.h>
#include <hip/hip_bf16.h>
#include <cstdio>
#include <cstdint>
#include <cmath>
namespace pg8 {
#define PG8_LAS __attribute__((address_space(3)))
typedef unsigned short bf16_t;
typedef short bf16x8 __attribute__((ext_vector_type(8)));
typedef float f32x4 __attribute__((ext_vector_type(4)));
typedef unsigned u32x4 __attribute__((ext_vector_type(4)));
constexpr int BM = 256, BK = 64, HALF = 128, HTB = HALF * BK * 2  , STAGE_BYTES = 8 * HTB, NXCD = 8, WGM = 8;

__host__ __device__ __forceinline__ int lds_byte(int r, int c) { const int st = (r >> 4) * 2 + (c >> 5), rr = r & 15, cc = c & 31, ob = rr * 64 + cc * 2; return st * 1024 + (ob ^ (((ob >> 9) & 1) << 5)); }
__host__ __device__ __forceinline__ void stage_rc(int b, int& R, int& C) { const int st = b / 1024, sb = b % 1024, swz = sb ^ (((sb >> 9) & 1) << 5); R = (st >> 1) * 16 + swz / 64; C = (st & 1) * 32 + (swz % 64) / 2; }
__host__ __device__ __forceinline__ int perm32(int rho) { const int n = rho >> 4, i = rho & 15; return 8 * (i >> 2) + 4 * n + (i & 3); }

struct Unit { int pm, pn; };
struct Gemm { const bf16_t* A; const bf16_t* Bt; int M, N, K;
    const int* glist = nullptr; const PG8_LAS int* gtb = nullptr; int gshift = 0, gT = 0; };

struct StaticOrder {
    int nM, nN, nwg, G, c;
    __host__ __device__ void init(int M, int N, int G_, int c_) { nM = M / BM; nN = N / BM; nwg = nM * nN; G = G_; c = c_; }
    __host__ __device__ bool next(int i, Unit& u) const {
        const long L = (long)i * G + c; if (L >= nwg) return false;
        int wgid = (int)L; { const int q = nwg / NXCD, r = nwg % NXCD, xcd = wgid % NXCD, off = wgid / NXCD; wgid = (xcd < r ? xcd * (q + 1) : r * (q + 1) + (xcd - r) * q) + off; }
        const int nig = WGM * nN, gid = wgid / nig, fm = gid * WGM, gsz = (nM - fm) < WGM ? (nM - fm) : WGM;
        u.pm = fm + ((wgid % nig) % gsz); u.pn = (wgid % nig) / gsz; return true;
    }
    __device__ __forceinline__ void a_ready(const Unit&) const {}
    __device__ __forceinline__ void done(const Unit&) const {}
};

__device__ __forceinline__ unsigned cvt_pk_bf16(float lo, float hi) { unsigned r; asm volatile("v_cvt_pk_bf16_f32 %0, %1, %2" : "=v"(r) : "v"(lo), "v"(hi)); return r; }
typedef float f32x2 __attribute__((ext_vector_type(2)));
__device__ __forceinline__ f32x2 gelu_pk(f32x2 v) {
    const f32x2 av = __builtin_elementwise_abs(v), d = av * 0.2316418882f + 1.0f;
    f32x2 t; t.x = __builtin_amdgcn_rcpf(d.x); t.y = __builtin_amdgcn_rcpf(d.y);
    f32x2 q = t * 0.5307027145f + (-0.7265760135f); q = q * t + 0.7107068705f; q = q * t + (-0.142248368f); q = q * t + 0.127414796f; q = q * t;
    const f32x2 s = (v * v) * (-0.72134752044f);
    f32x2 e; e.x = __builtin_amdgcn_exp2f(s.x); e.y = __builtin_amdgcn_exp2f(s.y);
    const f32x2 m = v * (q * e), r = v - m;
    f32x2 o; o.x = v.x < 0.f ? m.x : r.x; o.y = v.y < 0.f ? m.y : r.y; return o;
}

template <int ACT  > struct EpiBf16 {
    static constexpr bool PERM = true, AFTER_DRAIN = false; static_assert(ACT == 0 || ACT == 1, "EpiBf16: ACT is 0 (none) or 1 (gelu_pk)");
    bf16_t* O; int ldc; const float* bias; int split_cols; size_t split_stride; float scale0;
    __device__ __forceinline__ void operator()(const f32x4 (&acc)[2][2][4][2], const Unit& u, int wr, int wc, int fr, int fq) const {
        const int row0 = u.pm * BM + wr * 64 + fr; int colt = u.pn * BM; bf16_t* base = O;
        float sc = 1.f; if (split_cols) { const int t = colt / split_cols; base += (size_t)t * split_stride; colt -= t * split_cols; if (t == 0) sc = scale0; }
        const int col0 = colt + wc * 32 + 8 * fq, bcol0 = u.pn * BM + wc * 32 + 8 * fq;
        f32x4 bv[2][2];
#pragma unroll
        for (int bj = 0; bj < 2; ++bj)
#pragma unroll
            for (int n = 0; n < 2; ++n) bv[bj][n] = bias ? *(const f32x4*)(bias + bcol0 + bj * HALF + 4 * n) : (f32x4){0.f, 0.f, 0.f, 0.f};
#pragma unroll
        for (int ai = 0; ai < 2; ++ai)
#pragma unroll
            for (int m = 0; m < 4; ++m) { bf16_t* rowp = base + (size_t)(row0 + ai * HALF + m * 16) * ldc + col0;
#pragma unroll
                for (int bj = 0; bj < 2; ++bj) { f32x4 v0 = acc[ai][bj][m][0] + bv[bj][0], v1 = acc[ai][bj][m][1] + bv[bj][1];
                    if (ACT == 1) { f32x2 a = gelu_pk((f32x2){v0[0], v0[1]}), b = gelu_pk((f32x2){v0[2], v0[3]}), c = gelu_pk((f32x2){v1[0], v1[1]}), d = gelu_pk((f32x2){v1[2], v1[3]});
                        v0 = (f32x4){a.x, a.y, b.x, b.y}; v1 = (f32x4){c.x, c.y, d.x, d.y}; }
                    v0 = v0 * sc; v1 = v1 * sc; u32x4 w; w.x = cvt_pk_bf16(v0[0], v0[1]); w.y = cvt_pk_bf16(v0[2], v0[3]); w.z = cvt_pk_bf16(v1[0], v1[1]); w.w = cvt_pk_bf16(v1[2], v1[3]);
                    *(u32x4*)(rowp + bj * HALF) = w; } }
    }
};
typedef int v8i_t __attribute__((ext_vector_type(8)));
typedef int v4i_t __attribute__((ext_vector_type(4)));
__device__ __forceinline__ v8i_t cat8(bf16x8 a, bf16x8 b) { const v4i_t x = __builtin_bit_cast(v4i_t, a), y = __builtin_bit_cast(v4i_t, b); return (v8i_t){x[0], x[1], x[2], x[3], y[0], y[1], y[2], y[3]}; }
__device__ __forceinline__ void mfma8_inplace(f32x4& c, v8i_t a, v8i_t b, int sa, int sb) {
    asm volatile("v_mfma_scale_f32_16x16x128_f8f6f4 %0, %1, %2, %0, %3, %4 op_sel_hi:[0,0,0]" : "+v"(c) : "v"(a), "v"(b), "v"(sa), "v"(sb)); }
template <class Epi, class Sched, bool ALIGN_EPI = false, bool SP2 = false, bool FP8 = false, bool GATHER = false>
__device__ __forceinline__ void gemm_phase(PG8_LAS unsigned char* lds, const Gemm g, const Sched& S, const Epi& E) {
    const int tid = threadIdx.x, wid = __builtin_amdgcn_readfirstlane(tid >> 6), lane = tid & 63, wr = wid >> 2, wc = wid & 3, fr = lane & 15, fq = lane >> 4;
    const int K = g.K, nt = K / BK;
    int sc_w = 0x7a7a7a7a, sc_a = 0x7f7f7f7f; if constexpr (FP8) { asm volatile("" : "+v"(sc_w), "+v"(sc_a)); }
    unsigned voffA[2], voffB[2]; int Ri[2]; unsigned Cb[2];
#pragma unroll
    for (int i = 0; i < 2; ++i) { int R, C; stage_rc(tid * 16 + i * 8192, R, C); const int Rb = Epi::PERM ? ((R & ~31) + perm32(R & 31)) : R;
        voffA[i] = (unsigned)(R * K + C) * 2u; voffB[i] = (unsigned)(Rb * K + C) * 2u; Ri[i] = R; Cb[i] = (unsigned)C * 2u; }
    unsigned gc[2][2] = {{0u, 0u}, {0u, 0u}}, gn[2][2] = {{0u, 0u}, {0u, 0u}}; int tkn[2][2] = {{0, 0}, {0, 0}};
    const size_t kstep = (size_t)(BK * 2);
    const size_t hstep = (size_t)HALF * K * 2;
    const size_t tstep = 2 * hstep;
    const unsigned ldsw = (unsigned)wid * 1024u;
    const int aoff = lds_byte(wr * 64 + fr, fq * 8), boff = lds_byte(wc * 32 + fr, fq * 8);
#define PG8_SA(b, h) (((b) * 2 + (h)) * HTB)
#define PG8_SB(b, h) ((4 + (b) * 2 + (h)) * HTB)
#define PG8_STAGE(bufoff, gbase, voff) do { _Pragma("unroll") for (int _i = 0; _i < 2; ++_i) \
        __builtin_amdgcn_global_load_lds((const unsigned*)((const char*)(gbase) + (voff)[_i]), (PG8_LAS unsigned*)(lds + (bufoff) + ldsw + _i * 8192), 16, 0, 0); } while (0)
#define PG8_TOK(u, tk) do { const int e_ = (u).pn >> g.gshift; const int* lp_ = g.glist + (size_t)e_ * g.gT + ((u).pm - g.gtb[e_]) * BM; \
        _Pragma("unroll") for (int h_ = 0; h_ < 2; ++h_) _Pragma("unroll") for (int i_ = 0; i_ < 2; ++i_) tk[h_][i_] = lp_[h_ * HALF + Ri[i_]]; } while (0)
#define PG8_GOFF(tk, go) do { _Pragma("unroll") for (int h_ = 0; h_ < 2; ++h_) _Pragma("unroll") for (int i_ = 0; i_ < 2; ++i_) { const int t_ = (unsigned)tk[h_][i_] < (unsigned)g.gT ? tk[h_][i_] : 0; \
        go[h_][i_] = (unsigned)t_ * (unsigned)(K * 2) + Cb[i_]; } } while (0)
#define PG8_STAGE_A(bufoff, ptr, h, nx) do { if constexpr (GATHER) { unsigned vo_[2]; vo_[0] = (nx) ? gn[h][0] : gc[h][0]; vo_[1] = (nx) ? gn[h][1] : gc[h][1]; PG8_STAGE(bufoff, ptr, vo_); } \
        else { PG8_STAGE(bufoff, (ptr) + ((h) ? hstep : (size_t)0), voffA); } } while (0)
#define PG8_LDA(dst, b, h) do { _Pragma("unroll") for (int m = 0; m < 4; ++m) _Pragma("unroll") for (int k = 0; k < 2; ++k) dst[m][k] = *(const PG8_LAS bf16x8*)(lds + PG8_SA(b, h) + aoff + m * 2048 + k * 1024); } while (0)
#define PG8_LDB(dst, b, h) do { _Pragma("unroll") for (int n = 0; n < 2; ++n) _Pragma("unroll") for (int k = 0; k < 2; ++k) dst[n][k] = *(const PG8_LAS bf16x8*)(lds + PG8_SB(b, h) + boff + n * 2048 + k * 1024); } while (0)
#define PG8_MMA(ai, bj, At, Bt) do { __builtin_amdgcn_s_setprio(1); if constexpr (FP8) { _Pragma("unroll") for (int m = 0; m < 4; ++m) _Pragma("unroll") for (int n = 0; n < 2; ++n) \
        mfma8_inplace(acc[ai][bj][m][n], cat8(Bt[n][0], Bt[n][1]), cat8(At[m][0], At[m][1]), sc_w, sc_a); } else { \
        _Pragma("unroll") for (int m = 0; m < 4; ++m) _Pragma("unroll") for (int n = 0; n < 2; ++n) _Pragma("unroll") for (int k = 0; k < 2; ++k) \
        acc[ai][bj][m][n] = __builtin_amdgcn_mfma_f32_16x16x32_bf16(Bt[n][k], At[m][k], acc[ai][bj][m][n], 0, 0, 0); } __builtin_amdgcn_s_setprio(0); } while (0)
#define PG8_WAIT_V(n) asm volatile("s_waitcnt vmcnt(" #n ")" ::: "memory")
#define PG8_WAIT_L(n) asm volatile("s_waitcnt lgkmcnt(" #n ")" ::: "memory")
#define PG8_BAR __builtin_amdgcn_s_barrier()
#define PG8_SCHED __builtin_amdgcn_sched_barrier(0)
    Unit cur, nxt; int ui = 0;
    if (!S.next(0, cur)) return;
    f32x4 acc[2][2][4][2];
#pragma unroll
    for (int a = 0; a < 2; ++a)
#pragma unroll
        for (int b = 0; b < 2; ++b)
#pragma unroll
            for (int m = 0; m < 4; ++m)
#pragma unroll
                for (int n = 0; n < 2; ++n) acc[a][b][m][n] = (f32x4){0.f, 0.f, 0.f, 0.f};
    bf16x8 At[4][2], B0[2][2], B1[2][2];
    const char* cA = (const char*)g.A + (GATHER ? (size_t)0 : (size_t)cur.pm * tstep); const char* cB = (const char*)g.Bt + (size_t)cur.pn * tstep;
    if constexpr (GATHER) { PG8_TOK(cur, tkn); PG8_GOFF(tkn, gc); Unit n1_; if (S.next(1, n1_)) PG8_TOK(n1_, tkn); }
    S.a_ready(cur);
    if constexpr (SP2) {
        PG8_STAGE(PG8_SB(0, 0), cB, voffB); PG8_STAGE(PG8_SB(0, 1), cB + hstep, voffB); PG8_STAGE_A(PG8_SA(0, 0), cA, 0, false); PG8_STAGE_A(PG8_SA(0, 1), cA, 1, false);
        if (wr == 1) PG8_BAR;
        PG8_WAIT_V(2); PG8_BAR;
        PG8_STAGE(PG8_SB(1, 0), cB + kstep, voffB); PG8_STAGE_A(PG8_SA(1, 0), cA + kstep, 0, false); PG8_STAGE(PG8_SB(1, 1), cB + hstep + kstep, voffB);
        PG8_WAIT_V(6); PG8_BAR;
    } else {
        PG8_STAGE(PG8_SB(0, 0), cB, voffB); PG8_STAGE_A(PG8_SA(0, 0), cA, 0, false); PG8_STAGE(PG8_SB(0, 1), cB + hstep, voffB); PG8_STAGE_A(PG8_SA(0, 1), cA, 1, false);
        if (wr == 1) PG8_BAR;
        PG8_WAIT_V(4); PG8_BAR;
        PG8_STAGE(PG8_SB(1, 0), cB + kstep, voffB); PG8_STAGE_A(PG8_SA(1, 0), cA + kstep, 0, false); PG8_STAGE(PG8_SB(1, 1), cB + hstep + kstep, voffB);
        PG8_WAIT_V(6); PG8_BAR;
    }
    for (;;) {
        const bool has_next = S.next(ui + 1, nxt);
        const char* nA = (has_next && !GATHER) ? (const char*)g.A + (size_t)nxt.pm * tstep : cA; const char* nB = has_next ? (const char*)g.Bt + (size_t)nxt.pn * tstep : cB;
        if constexpr (GATHER) { if (has_next) { PG8_GOFF(tkn, gn); } else { gn[0][0] = gc[0][0]; gn[0][1] = gc[0][1]; gn[1][0] = gc[1][0]; gn[1][1] = gc[1][1]; }
            Unit n2_; if (S.next(ui + 2, n2_)) PG8_TOK(n2_, tkn); }
        for (int t = 0; t < nt; t += 2) {
            const bool last = (t == nt - 2);
            const char* a1 = cA + (size_t)(t + 1) * kstep;
            const char* a2 = last ? nA : cA + (size_t)(t + 2) * kstep; const char* b2 = last ? nB : cB + (size_t)(t + 2) * kstep;
            const char* a3 = a2 + kstep; const char* b3 = b2 + kstep;
            if (last && has_next) S.a_ready(nxt);
            if constexpr (SP2) {
            PG8_LDB(B0, 0, 0); PG8_LDB(B1, 0, 1); PG8_SCHED; PG8_LDA(At, 0, 0); PG8_STAGE_A(PG8_SA(1, 1), a1, 1, false);
            PG8_WAIT_V(8); PG8_WAIT_L(0); PG8_BAR; PG8_MMA(0, 0, At, B0); PG8_MMA(0, 1, At, B1); PG8_BAR; PG8_SCHED;
            PG8_LDA(At, 0, 1); PG8_STAGE(PG8_SB(0, 0), b2, voffB); PG8_STAGE(PG8_SB(0, 1), b2 + hstep, voffB); PG8_STAGE_A(PG8_SA(0, 0), a2, 0, last);
            PG8_WAIT_V(8); PG8_WAIT_L(0); PG8_BAR; PG8_MMA(1, 0, At, B0); PG8_MMA(1, 1, At, B1); PG8_BAR; PG8_SCHED;
            PG8_LDB(B0, 1, 0); PG8_LDB(B1, 1, 1); PG8_SCHED; PG8_LDA(At, 1, 0); PG8_STAGE_A(PG8_SA(0, 1), a2, 1, last);
            PG8_WAIT_V(8); PG8_WAIT_L(0); PG8_BAR; PG8_MMA(0, 0, At, B0); PG8_MMA(0, 1, At, B1); PG8_BAR; PG8_SCHED;
            PG8_LDA(At, 1, 1); PG8_STAGE(PG8_SB(1, 0), b3, voffB); PG8_STAGE(PG8_SB(1, 1), b3 + hstep, voffB); PG8_STAGE_A(PG8_SA(1, 0), a3, 0, last);
            PG8_WAIT_V(8); PG8_WAIT_L(0); PG8_BAR; PG8_MMA(1, 0, At, B0); PG8_MMA(1, 1, At, B1); PG8_BAR; PG8_SCHED;
            } else {
            PG8_LDB(B0, 0, 0); PG8_SCHED; PG8_LDA(At, 0, 0); PG8_STAGE_A(PG8_SA(1, 1), a1, 1, false);
            PG8_WAIT_L(8); PG8_BAR; PG8_WAIT_L(0); PG8_MMA(0, 0, At, B0); PG8_BAR; PG8_SCHED;
            PG8_LDB(B1, 0, 1); PG8_STAGE(PG8_SB(0, 0), b2, voffB);
            PG8_BAR; PG8_WAIT_L(0); PG8_MMA(0, 1, At, B1); PG8_BAR;
            PG8_LDA(At, 0, 1); PG8_STAGE_A(PG8_SA(0, 0), a2, 0, last);
            PG8_BAR; PG8_WAIT_L(0); PG8_MMA(1, 0, At, B0); PG8_BAR; PG8_SCHED;
            PG8_STAGE(PG8_SB(0, 1), b2 + hstep, voffB);
            PG8_WAIT_V(6); PG8_BAR; PG8_MMA(1, 1, At, B1); PG8_BAR;
            PG8_LDB(B0, 1, 0); PG8_SCHED; PG8_LDA(At, 1, 0); PG8_STAGE_A(PG8_SA(0, 1), a2, 1, last);
            PG8_WAIT_L(8); PG8_BAR; PG8_WAIT_L(0); PG8_MMA(0, 0, At, B0); PG8_BAR; PG8_SCHED;
            PG8_LDB(B1, 1, 1); PG8_STAGE(PG8_SB(1, 0), b3, voffB);
            PG8_BAR; PG8_WAIT_L(0); PG8_MMA(0, 1, At, B1); PG8_BAR;
            PG8_LDA(At, 1, 1); PG8_STAGE_A(PG8_SA(1, 0), a3, 0, last);
            PG8_BAR; PG8_WAIT_L(0); PG8_MMA(1, 0, At, B0); PG8_BAR; PG8_SCHED;
            PG8_STAGE(PG8_SB(1, 1), b3 + hstep, voffB);
            PG8_WAIT_V(6); PG8_BAR; PG8_MMA(1, 1, At, B1); PG8_BAR;
            }
        }
        if constexpr (FP8) asm volatile("s_nop 15\n\ts_nop 15" ::: "memory");
        if constexpr (ALIGN_EPI) { if (wr == 0) PG8_BAR; }
        if constexpr (!Epi::AFTER_DRAIN) { E(acc, cur, wr, wc, fr, fq); S.done(cur); }
        if (!has_next) break;
#pragma unroll
        for (int a = 0; a < 2; ++a)
#pragma unroll
            for (int b = 0; b < 2; ++b)
#pragma unroll
                for (int m = 0; m < 4; ++m)
#pragma unroll
                    for (int n = 0; n < 2; ++n) acc[a][b][m][n] = (f32x4){0.f, 0.f, 0.f, 0.f};
        cur = nxt; cA = nA; cB = nB; ++ui;
        if constexpr (GATHER) { gc[0][0] = gn[0][0]; gc[0][1] = gn[0][1]; gc[1][0] = gn[1][0]; gc[1][1] = gn[1][1]; }
        if constexpr (ALIGN_EPI) { if (wr == 1) PG8_BAR; }
    }
    PG8_WAIT_V(0);
    if constexpr (!ALIGN_EPI) { if (wr == 0) PG8_BAR; }
    PG8_BAR;
    if constexpr (Epi::AFTER_DRAIN) { E.fused(acc, cur, wr, wc, fr, fq, lds, wid, lane); S.done(cur); }
#undef PG8_TOK
#undef PG8_GOFF
#undef PG8_STAGE_A
#undef PG8_SA
#undef PG8_SB
#undef PG8_STAGE
#undef PG8_LDA
#undef PG8_LDB
#undef PG8_MMA
#undef PG8_WAIT_V
#undef PG8_WAIT_L
#undef PG8_BAR
#undef PG8_SCHED
}
__device__ __forceinline__ float bf_lo(unsigned w) { return __uint_as_float(w << 16); }
__device__ __forceinline__ float bf_hi(unsigned w) { return __uint_as_float(w & 0xffff0000u); }
__device__ __forceinline__ float sigmoidf_(float x) { return __builtin_amdgcn_rcpf(1.0f + __expf(-x)); }
struct EpiGlu {
    static constexpr bool PERM = true, AFTER_DRAIN = false;
    const bf16_t* G; bf16_t* O; int ldc; const float* bias;
    __device__ __forceinline__ void operator()(const f32x4 (&acc)[2][2][4][2], const Unit& u, int wr, int wc, int fr, int fq) const {
        const int row0 = u.pm * BM + wr * 64 + fr, col0 = u.pn * BM + wc * 32 + 8 * fq;
        f32x4 bv[2][2];
#pragma unroll
        for (int bj = 0; bj < 2; ++bj)
#pragma unroll
            for (int n = 0; n < 2; ++n) bv[bj][n] = *(const f32x4*)(bias + col0 + bj * HALF + 4 * n);
#pragma unroll
        for (int ai = 0; ai < 2; ++ai)
#pragma unroll
            for (int m = 0; m < 4; ++m) { const size_t ro = (size_t)(row0 + ai * HALF + m * 16) * ldc + col0;
#pragma unroll
                for (int bj = 0; bj < 2; ++bj) { const f32x4 v0 = acc[ai][bj][m][0] + bv[bj][0], v1 = acc[ai][bj][m][1] + bv[bj][1];
                    const u32x4 g = *(const u32x4*)(G + ro + bj * HALF);
                    const float o0 = bf_lo(g.x) * sigmoidf_(v0[0]), o1 = bf_hi(g.x) * sigmoidf_(v0[1]), o2 = bf_lo(g.y) * sigmoidf_(v0[2]), o3 = bf_hi(g.y) * sigmoidf_(v0[3]);
                    const float o4 = bf_lo(g.z) * sigmoidf_(v1[0]), o5 = bf_hi(g.z) * sigmoidf_(v1[1]), o6 = bf_lo(g.w) * sigmoidf_(v1[2]), o7 = bf_hi(g.w) * sigmoidf_(v1[3]);
                    u32x4 w; w.x = cvt_pk_bf16(o0, o1); w.y = cvt_pk_bf16(o2, o3); w.z = cvt_pk_bf16(o4, o5); w.w = cvt_pk_bf16(o6, o7);
                    *(u32x4*)(O + ro + bj * HALF) = w; } }
    }
};
struct EpiResF32 {
    static constexpr bool PERM = false, AFTER_DRAIN = false;
    const float* base; float* out; int ldc;
    __device__ __forceinline__ void operator()(const f32x4 (&acc)[2][2][4][2], const Unit& u, int wr, int wc, int fr, int fq) const {
        const int col0 = u.pn * BM + wc * 32 + 4 * fq;
#pragma unroll
        for (int ai = 0; ai < 2; ++ai)
#pragma unroll
            for (int m = 0; m < 4; ++m) { const size_t off = (size_t)(u.pm * BM + ai * HALF + wr * 64 + m * 16 + fr) * ldc + col0;
#pragma unroll
                for (int bj = 0; bj < 2; ++bj)
#pragma unroll
                    for (int n = 0; n < 2; ++n) { const f32x4 bs = *(const f32x4*)(base + off + bj * HALF + n * 16); *(f32x4*)(out + off + bj * HALF + n * 16) = bs + acc[ai][bj][m][n]; } }
    }
};
struct EpiResBf16 {
    static constexpr bool PERM = true, AFTER_DRAIN = false;
    const float* base; bf16_t* out; int ldc;
    __device__ __forceinline__ void operator()(const f32x4 (&acc)[2][2][4][2], const Unit& u, int wr, int wc, int fr, int fq) const {
        const int row0 = u.pm * BM + wr * 64 + fr, col0 = u.pn * BM + wc * 32 + 8 * fq;
#pragma unroll
        for (int ai = 0; ai < 2; ++ai)
#pragma unroll
            for (int m = 0; m < 4; ++m) { const size_t ro = (size_t)(row0 + ai * HALF + m * 16) * ldc + col0;
#pragma unroll
                for (int bj = 0; bj < 2; ++bj) { const f32x4 b0 = __builtin_nontemporal_load((const f32x4*)(base + ro + bj * HALF)), b1 = __builtin_nontemporal_load((const f32x4*)(base + ro + bj * HALF + 4));
                    const f32x4 v0 = acc[ai][bj][m][0] + b0, v1 = acc[ai][bj][m][1] + b1;
                    u32x4 w; w.x = cvt_pk_bf16(v0[0], v0[1]); w.y = cvt_pk_bf16(v0[2], v0[3]); w.z = cvt_pk_bf16(v1[0], v1[1]); w.w = cvt_pk_bf16(v1[2], v1[3]);
                    *(u32x4*)(out + ro + bj * HALF) = w; } }
    }
};
struct EpiSwiglu {
    static constexpr bool PERM = true, AFTER_DRAIN = false;
    bf16_t* O; int ldo; const float* bg; const float* bu;
    __device__ __forceinline__ void operator()(const f32x4 (&acc)[2][2][4][2], const Unit& u, int wr, int wc, int fr, int fq) const {
        const int e = u.pn >> 4, j = u.pn & 15, col0 = j * HALF + wc * 32 + 8 * fq, row0 = u.pm * BM + wr * 64 + fr;
        f32x4 g_b[2], u_b[2];
#pragma unroll
        for (int n = 0; n < 2; ++n) { g_b[n] = *(const f32x4*)(bg + (size_t)e * 2048 + col0 + 4 * n); u_b[n] = *(const f32x4*)(bu + (size_t)e * 2048 + col0 + 4 * n); }
#pragma unroll
        for (int ai = 0; ai < 2; ++ai)
#pragma unroll
            for (int m = 0; m < 4; ++m) { float h[8];
#pragma unroll
                for (int n = 0; n < 2; ++n)
#pragma unroll
                    for (int i = 0; i < 4; ++i) { const float g = fminf(acc[ai][0][m][n][i] + g_b[n][i], 7.0f); const float uu = fminf(fmaxf(acc[ai][1][m][n][i] + u_b[n][i], -7.0f), 7.0f);
                        h[n * 4 + i] = g * sigmoidf_(1.702f * g) * (uu + 1.0f); }
                u32x4 w; w.x = cvt_pk_bf16(h[0], h[1]); w.y = cvt_pk_bf16(h[2], h[3]); w.z = cvt_pk_bf16(h[4], h[5]); w.w = cvt_pk_bf16(h[6], h[7]);
                *(u32x4*)(O + (size_t)(row0 + ai * HALF + m * 16) * ldo + col0) = w; }
    }
};
__device__ __forceinline__ float sat8(float v) { return __builtin_amdgcn_fmed3f(v, -448.0f, 448.0f); }
__device__ __forceinline__ unsigned pk4_fp8(float a, float b, float c, float d) { int w = 0; w = __builtin_amdgcn_cvt_pk_fp8_f32(a, b, w, false); w = __builtin_amdgcn_cvt_pk_fp8_f32(c, d, w, true); return (unsigned)w; }
struct EpiSwiglu8 {
    static constexpr bool PERM = true, AFTER_DRAIN = false;
    unsigned char* O; int ldo; const float* bg; const float* bu;
    __device__ __forceinline__ void operator()(const f32x4 (&acc)[2][2][4][2], const Unit& u, int wr, int wc, int fr, int fq) const {
        const int e = u.pn >> 4, j = u.pn & 15, col0 = j * HALF + wc * 32 + 8 * fq, row0 = u.pm * BM + wr * 64 + fr;
        f32x4 g_b[2], u_b[2];
#pragma unroll
        for (int n = 0; n < 2; ++n) { g_b[n] = *(const f32x4*)(bg + (size_t)e * 2048 + col0 + 4 * n); u_b[n] = *(const f32x4*)(bu + (size_t)e * 2048 + col0 + 4 * n); }
#pragma unroll
        for (int ai = 0; ai < 2; ++ai)
#pragma unroll
            for (int m = 0; m < 4; ++m) { float h[8];
#pragma unroll
                for (int n = 0; n < 2; ++n)
#pragma unroll
                    for (int i = 0; i < 4; ++i) { const float g = fminf(acc[ai][0][m][n][i] + g_b[n][i], 7.0f); const float uu = fminf(fmaxf(acc[ai][1][m][n][i] + u_b[n][i], -7.0f), 7.0f);
                        h[n * 4 + i] = g * sigmoidf_(1.702f * g) * (uu + 1.0f); }
                typedef unsigned u32x2_t __attribute__((ext_vector_type(2)));
                u32x2_t w; w.x = pk4_fp8(h[0], h[1], h[2], h[3]); w.y = pk4_fp8(h[4], h[5], h[6], h[7]);
                *(u32x2_t*)(O + (size_t)(row0 + ai * HALF + m * 16) * ldo + col0) = w; }
    }
};
struct EpiFp8 {
    static constexpr bool PERM = true, AFTER_DRAIN = false;
    unsigned char* O; int ldc; const float* bias; int ncols;
    __device__ __forceinline__ void operator()(const f32x4 (&acc)[2][2][4][2], const Unit& u, int wr, int wc, int fr, int fq) const {
        const int row0 = u.pm * BM + wr * 64 + fr, bcol0 = u.pn * BM + wc * 32 + 8 * fq, col0 = bcol0 % ncols;
        f32x4 bv[2][2];
#pragma unroll
        for (int bj = 0; bj < 2; ++bj)
#pragma unroll
            for (int n = 0; n < 2; ++n) bv[bj][n] = *(const f32x4*)(bias + bcol0 + bj * HALF + 4 * n);
        typedef unsigned u32x2_t __attribute__((ext_vector_type(2)));
#pragma unroll
        for (int ai = 0; ai < 2; ++ai)
#pragma unroll
            for (int m = 0; m < 4; ++m) { unsigned char* rowp = O + (size_t)(row0 + ai * HALF + m * 16) * ldc + col0;
#pragma unroll
                for (int bj = 0; bj < 2; ++bj) { const f32x4 v0 = acc[ai][bj][m][0] + bv[bj][0], v1 = acc[ai][bj][m][1] + bv[bj][1];
                    u32x2_t w; w.x = pk4_fp8(sat8(v0[0]), sat8(v0[1]), sat8(v0[2]), sat8(v0[3])); w.y = pk4_fp8(sat8(v1[0]), sat8(v1[1]), sat8(v1[2]), sat8(v1[3]));
                    *(u32x2_t*)(rowp + bj * HALF) = w; } }
    }
};
struct MoeOrder {
    const PG8_LAS int* tb; int NT, G, c;
    __device__ __forceinline__ bool next(int i, Unit& u) const {
        const int x = c & 7, k = c >> 3, G8 = G >> 3, NL = NT >> 3;
        const long L = (long)i * G8 + k; const int total = tb[32] * NL; if (L >= (long)total) return false;
        int e = 0;
#pragma unroll 8
        for (int q = 1; q <= 32; ++q) e += (L >= (long)tb[q] * NL) ? 1 : 0;
        e = e > 31 ? 31 : e;
        const int t0 = tb[e], ne = tb[e + 1] - t0, r = (int)(L - (long)t0 * NL), nn = ne > 0 ? ne : 1;
        u.pn = __builtin_amdgcn_readfirstlane(e * NT + x * NL + r / nn); u.pm = __builtin_amdgcn_readfirstlane(t0 + r % nn); return true;
    }
    __device__ __forceinline__ void a_ready(const Unit&) const {}
    __device__ __forceinline__ void done(const Unit&) const {}
};
}
namespace att {
using bf16 = __hip_bfloat16;
constexpr int   D = 128, NW = 8, QBLK = 32, KVBLK = 64;
constexpr float SCALE = 0.088388347648318440f;
constexpr float THR = 0.f;
constexpr int LDQ = 1024, LDK = 1024, LDO = 1024;
constexpr size_t SHM_V = KVBLK * D * 2, SHM_K = KVBLK * D * 2, SHM_ATTN = 2 * SHM_V + 2 * SHM_K + NW * 64 * 4 + 1040;
using bf16x8 = __attribute__((ext_vector_type(8))) short;
using s16x4  = __attribute__((ext_vector_type(4))) short;
using f32x16 = __attribute__((ext_vector_type(16))) float;
using f32x8  = __attribute__((ext_vector_type(8))) float;
using u32x4  = __attribute__((ext_vector_type(4))) unsigned;
#define KSWZ(row, colB) ((row) * 256 + ((colB) ^ (((row) & 7) << 4)))
#define SBAR() __builtin_amdgcn_sched_barrier(0)
__device__ __forceinline__ int crow(int r, int hi) { return (r & 3) + 8 * (r >> 2) + 4 * hi; }
__device__ __forceinline__ unsigned cvtpk(float lo, float hi) {
  unsigned r; asm volatile("v_cvt_pk_bf16_f32 %0, %1, %2" : "=v"(r) : "v"(lo), "v"(hi)); return r;
}
template <typename TIn> struct Stage;
template <> struct Stage<bf16>  { using T = bf16x8;
  __device__ static __forceinline__ T ld8(const bf16* p) { return *reinterpret_cast<const bf16x8*>(p); }
  __device__ static __forceinline__ bf16x8 tobf(T x) { return x; } };
template <> struct Stage<float> { using T = f32x8;
  __device__ static __forceinline__ T ld8(const float* p) { return *reinterpret_cast<const f32x8*>(p); }
  __device__ static __forceinline__ bf16x8 tobf(T x) {
    u32x4 w = {cvtpk(x[0], x[1]), cvtpk(x[2], x[3]), cvtpk(x[4], x[5]), cvtpk(x[6], x[7])}; return *reinterpret_cast<bf16x8*>(&w); } };

__device__ __forceinline__ void partialSM(f32x16& p0, f32x16& p1, float& m_reg, float& mn, float& alpha) {
  constexpr float C = SCALE * 1.4426950408889634f;
  float pmax = p0[0]; for (int r = 1; r < 16; ++r) pmax = fmaxf(pmax, p0[r]); for (int r = 0; r < 16; ++r) pmax = fmaxf(pmax, p1[r]);
  { auto rr = __builtin_amdgcn_permlane32_swap(__float_as_uint(pmax), __float_as_uint(pmax), false, false);
    pmax = fmaxf(__uint_as_float(rr[0]), __uint_as_float(rr[1])); }
  if (__builtin_expect(__all(pmax - m_reg <= THR / SCALE), 1)) { mn = m_reg; alpha = 1.f; }
  else { mn = fmaxf(m_reg, pmax); alpha = __builtin_amdgcn_exp2f((m_reg - mn) * C); m_reg = mn; }
  float mnC = -mn * C;
  for (int r = 0; r < 16; ++r) p0[r] = fmaf(p0[r], C, mnC); for (int r = 0; r < 16; ++r) p1[r] = fmaf(p1[r], C, mnC);
  for (int r = 0; r < 16; ++r) p0[r] = __builtin_amdgcn_exp2f(p0[r]);
}
__device__ __forceinline__ void finishSM(f32x16& p0, f32x16& p1, float alpha, float& l_reg, bf16x8& pa0, bf16x8& pa1, bf16x8& pa2, bf16x8& pa3) {
  for (int r = 0; r < 16; ++r) p1[r] = __builtin_amdgcn_exp2f(p1[r]);
  float ps = 0; for (int r = 0; r < 16; ++r) ps += p0[r]; for (int r = 0; r < 16; ++r) ps += p1[r];
  { auto rr = __builtin_amdgcn_permlane32_swap(__float_as_uint(ps), __float_as_uint(ps), false, false);
    ps = __uint_as_float(rr[0]) + __uint_as_float(rr[1]); }
  l_reg = l_reg * alpha + ps;
#define PK4(P, BASE, OUT) do { unsigned a0 = cvtpk(P[BASE + 0], P[BASE + 1]), a1 = cvtpk(P[BASE + 2], P[BASE + 3]);   \
    unsigned b0 = cvtpk(P[BASE + 4], P[BASE + 5]), b1 = cvtpk(P[BASE + 6], P[BASE + 7]);                              \
    auto r0 = __builtin_amdgcn_permlane32_swap(a0, b0, false, false); auto r1 = __builtin_amdgcn_permlane32_swap(a1, b1, false, false); \
    u32x4 w = {r0[0], r1[0], r0[1], r1[1]}; OUT = *reinterpret_cast<bf16x8*>(&w); } while (0)
  PK4(p0, 0, pa0); PK4(p0, 8, pa1); PK4(p1, 0, pa2); PK4(p1, 8, pa3);
#undef PK4
}
__device__ __forceinline__ void qkt(f32x16& p0, f32x16& p1, const bf16* Ks, const bf16x8* qr, int r32, int hi) {
  p0 = f32x16{}; p1 = f32x16{};
  for (int d0 = 0; d0 < 8; ++d0) { int cb = (d0 * 16 + hi * 8) * 2;
    bf16x8 b0 = *reinterpret_cast<const bf16x8*>((const char*)Ks + KSWZ(r32, cb));
    bf16x8 b1 = *reinterpret_cast<const bf16x8*>((const char*)Ks + KSWZ(32 + r32, cb));
    p0 = __builtin_amdgcn_mfma_f32_32x32x16_bf16(b0, qr[d0], p0, 0, 0, 0);
    p1 = __builtin_amdgcn_mfma_f32_32x32x16_bf16(b1, qr[d0], p1, 0, 0, 0); }
}
__device__ __forceinline__ int v_st(int k, int c) { const int kk = (k & ~0xC) | ((k & 4) << 1) | ((k & 8) >> 1); return ((kk >> 3) * 4 + (c >> 5)) * 512 + ((kk & 7) * 32 + (c & 31)) * 2; }
__device__ __forceinline__ int v_rd_base(int lane) { return ((lane & 3) << 3) | (((lane >> 2) & 3) << 6) | (((lane >> 4) & 1) << 5) | (((lane >> 5) & 1) << 8); }
constexpr int v_rd_off(int d0, int ks, int half) { return d0 * 512 + ks * 4096 + half * 2048; }
template <int OFF> __device__ __forceinline__ s16x4 tr_read(int vb) {
  s16x4 r; asm volatile("ds_read_b64_tr_b16 %0, %1 offset:%2" : "=&v"(r) : "v"(vb), "i"(OFF) : "memory"); return r;
}
template <int D0> __device__ __forceinline__ void pv_one(f32x16& od, int vb, bf16x8 pa0, bf16x8 pa1, bf16x8 pa2, bf16x8 pa3) {
  const s16x4 l0 = tr_read<v_rd_off(D0, 0, 0)>(vb), h0 = tr_read<v_rd_off(D0, 0, 1)>(vb), l1 = tr_read<v_rd_off(D0, 1, 0)>(vb), h1 = tr_read<v_rd_off(D0, 1, 1)>(vb);
  const s16x4 l2 = tr_read<v_rd_off(D0, 2, 0)>(vb), h2 = tr_read<v_rd_off(D0, 2, 1)>(vb), l3 = tr_read<v_rd_off(D0, 3, 0)>(vb), h3 = tr_read<v_rd_off(D0, 3, 1)>(vb);
  asm volatile("s_waitcnt lgkmcnt(0)" ::: "memory"); SBAR();
#define PK(L, H) (bf16x8){L[0], L[1], L[2], L[3], H[0], H[1], H[2], H[3]}
  od = __builtin_amdgcn_mfma_f32_32x32x16_bf16(pa0, PK(l0, h0), od, 0, 0, 0);
  od = __builtin_amdgcn_mfma_f32_32x32x16_bf16(pa1, PK(l1, h1), od, 0, 0, 0);
  od = __builtin_amdgcn_mfma_f32_32x32x16_bf16(pa2, PK(l2, h2), od, 0, 0, 0);
  od = __builtin_amdgcn_mfma_f32_32x32x16_bf16(pa3, PK(l3, h3), od, 0, 0, 0);
#undef PK
}
__device__ __forceinline__ void pv_d0(f32x16* o, int vb, bf16x8 pa0, bf16x8 pa1, bf16x8 pa2, bf16x8 pa3) {
  pv_one<0>(o[0], vb, pa0, pa1, pa2, pa3); pv_one<1>(o[1], vb, pa0, pa1, pa2, pa3); pv_one<2>(o[2], vb, pa0, pa1, pa2, pa3); pv_one<3>(o[3], vb, pa0, pa1, pa2, pa3);
}

__device__ __forceinline__ void bias_mask(f32x16& p0, f32x16& p1, int t, bool valid, int qi, int hi, const float* bt) {
  if (!valid) {
#pragma unroll
    for (int r = 0; r < 16; ++r) { p0[r] = -INFINITY; p1[r] = -INFINITY; }
  } else if (t <= 5) {
    const float c = bt[256];
#pragma unroll
    for (int r = 0; r < 16; ++r) { p0[r] += c; p1[r] += c; }
  } else {
    const int base = 512 + qi - 64 * t;
#pragma unroll
    for (int r = 0; r < 16; ++r) { const int kt = crow(r, hi);
      int r0 = base - kt; r0 = r0 < -128 ? -128 : (r0 > 128 ? 128 : r0);
      int r1 = base - kt - 32; r1 = r1 < -128 ? -128 : (r1 > 128 ? 128 : r1);
      p0[r] += bt[r0 + 128]; p1[r] += bt[r1 + 128]; }
  }
}
__device__ __forceinline__ void attn_unit(int b, int h, int qb, const bf16* __restrict__ Q, const bf16* __restrict__ K, const bf16* __restrict__ V, bf16* __restrict__ O,
                                          const float* __restrict__ rel_bias, char* lds) {
  using St = Stage<bf16>;
  const int tid = threadIdx.x, wid = __builtin_amdgcn_readfirstlane(tid >> 6), lane = tid & 63, r32 = lane & 31, hi = lane >> 5;
  bf16* V_lds = (bf16*)lds; bf16* K_lds = (bf16*)(lds + 2 * SHM_V);
  float* ws = (float*)(lds + 2 * SHM_V + 2 * SHM_K) + wid * 64; float* li_l = ws; float* al_l = ws + 32;
  float* bt = (float*)(lds + 2 * SHM_V + 2 * SHM_K + NW * 64 * 4);
  for (int i = tid; i < 257; i += 64 * NW) bt[i] = rel_bias[h * 257 + i] * (1.0f / SCALE);
  const long rowb = (long)b * 2048;
  const bf16* Qb = Q + (rowb + qb * 256) * LDQ + h * D;
  const bf16* Kh = K + rowb * LDK + h * D; const bf16* Vh = V + rowb * LDK + h * D;
  bf16* Ob = O + (rowb + qb * 256) * LDO + h * D;
  const int cbase = qb * 4 - 8;
  const int ci = wid >> 1, qi = (wid & 1) * 32 + r32;
  float m_reg = -1e30f, l_reg = 0; f32x16 o[4] = {}; bf16x8 qr[8];
  const bf16* Qw = Qb + (long)(wid * QBLK + r32) * LDQ + hi * 8;
#pragma unroll
  for (int d0 = 0; d0 < 8; ++d0) qr[d0] = St::tobf(St::ld8(Qw + d0 * 16));
  const int sr = tid >> 4, sc = (tid & 15) * 8, vst0 = v_st(sr, sc), vst1 = v_st(32 + sr, sc);
  const int vb0 = (int)(uintptr_t)V_lds + v_rd_base(lane);
  struct { typename St::T vs0, vs1, ks0, ks1; } sr_[2];
#define KSTART(j) ((((cbase + (j)) < 0) ? 0 : (cbase + (j))) * 64)
#define TVALID(j) (((j) - ci) >= 0 && ((j) - ci) <= 8 && (cbase + (j)) >= 0)
#define SLOAD(i, k0) do { sr_[i].vs0 = St::ld8(&Vh[(long)((k0) + sr) * LDK + sc]); sr_[i].vs1 = St::ld8(&Vh[(long)((k0) + 32 + sr) * LDK + sc]); \
    sr_[i].ks0 = St::ld8(&Kh[(long)((k0) + sr) * LDK + sc]); sr_[i].ks1 = St::ld8(&Kh[(long)((k0) + 32 + sr) * LDK + sc]); } while (0)
#define SWRITE(bb, i) do { *(bf16x8*)((char*)V_lds + (bb) * SHM_V + vst0) = St::tobf(sr_[i].vs0);          \
    *(bf16x8*)((char*)V_lds + (bb) * SHM_V + vst1) = St::tobf(sr_[i].vs1); int kc = sc * 2;               \
    *(bf16x8*)((char*)K_lds + (bb) * SHM_K + KSWZ(sr, kc)) = St::tobf(sr_[i].ks0);                       \
    *(bf16x8*)((char*)K_lds + (bb) * SHM_K + KSWZ(32 + sr, kc)) = St::tobf(sr_[i].ks1); } while (0)
#define SWAIT() asm volatile("s_waitcnt vmcnt(4)" ::: "memory")
#define RESC(a) do { if (__any((a) < 1.f)) { if (hi == 0) al_l[r32] = (a); asm volatile("s_waitcnt lgkmcnt(0)" ::: "memory"); \
    for (int d = 0; d < 4; ++d) for (int r = 0; r < 16; ++r) o[d][r] *= al_l[crow(r, hi)]; } } while (0)
  f32x16 pA0, pA1, pB0, pB1; float mnA, mnB, alA, alB; bf16x8 pa0, pa1, pa2, pa3; constexpr int NT = 12;
  constexpr int SE = 0, SO = 1;
  SLOAD(SE, KSTART(0)); asm volatile("s_waitcnt vmcnt(0)" ::: "memory"); SWRITE(0, SE); __syncthreads();
  qkt(pA0, pA1, K_lds, qr, r32, hi); bias_mask(pA0, pA1, 0 - ci, TVALID(0), qi, hi, bt); partialSM(pA0, pA1, m_reg, mnA, alA);
  SLOAD(SO, KSTART(1)); SLOAD(SE, KSTART(2));
  SWAIT(); SWRITE(1, SO); __syncthreads();
  for (int j = 1; j + 1 < NT; j += 2) {
    SBAR(); qkt(pB0, pB1, (bf16*)((char*)K_lds + SHM_K), qr, r32, hi);
    finishSM(pA0, pA1, alA, l_reg, pa0, pa1, pa2, pa3); SBAR();
    SLOAD(SO, KSTART(j + 2)); SBAR();
    pv_d0(o, vb0, pa0, pa1, pa2, pa3); bias_mask(pB0, pB1, j - ci, TVALID(j), qi, hi, bt); partialSM(pB0, pB1, m_reg, mnB, alB);
    __syncthreads(); SWAIT(); SWRITE(0, SE);
    RESC(alB); __syncthreads();
    SBAR(); qkt(pA0, pA1, K_lds, qr, r32, hi);
    finishSM(pB0, pB1, alB, l_reg, pa0, pa1, pa2, pa3); SBAR();
    if (j + 3 < NT) SLOAD(SE, KSTART(j + 3)); SBAR();
    pv_d0(o, vb0 + (int)SHM_V, pa0, pa1, pa2, pa3); bias_mask(pA0, pA1, j + 1 - ci, TVALID(j + 1), qi, hi, bt); partialSM(pA0, pA1, m_reg, mnA, alA);
    __syncthreads(); SWAIT(); SWRITE(1, SO);
    RESC(alA); __syncthreads();
  }
  SBAR(); qkt(pB0, pB1, (bf16*)((char*)K_lds + SHM_K), qr, r32, hi);
  finishSM(pA0, pA1, alA, l_reg, pa0, pa1, pa2, pa3); SBAR();
  pv_d0(o, vb0, pa0, pa1, pa2, pa3); bias_mask(pB0, pB1, NT - 1 - ci, TVALID(NT - 1), qi, hi, bt); partialSM(pB0, pB1, m_reg, mnB, alB);
  __syncthreads(); RESC(alB);
  finishSM(pB0, pB1, alB, l_reg, pa0, pa1, pa2, pa3); SBAR();
  pv_d0(o, vb0 + (int)SHM_V, pa0, pa1, pa2, pa3);
  if (hi == 0) li_l[r32] = l_reg; asm volatile("s_waitcnt lgkmcnt(0)" ::: "memory");
  float rli[16];
#pragma unroll
  for (int r = 0; r < 16; ++r) rli[r] = __builtin_amdgcn_rcpf(li_l[crow(r, hi)]);
  bf16* Ow = Ob + (long)(wid * QBLK) * LDO;
#pragma unroll
  for (int r = 0; r < 16; ++r) { const int orow = crow(r, hi);
#pragma unroll
    for (int d0 = 0; d0 < 4; ++d0) Ow[(long)orow * LDO + d0 * 32 + r32] = __float2bfloat16(o[d0][r] * rli[r]); }
  __syncthreads();
#undef KSTART
#undef TVALID
#undef SLOAD
#undef SWRITE
#undef SWAIT
#undef RESC
}
}
#define GAS __attribute__((address_space(1)))
#define LAS __attribute__((address_space(3)))
#define XB_TMO      128
#define XB_XCNT(j)  (256  + 64 * (j))
#define XB_XSUB(j)  (1280 + 64 * (j))
#define XB_XGEN(j)  (2304 + 64 * (j))
#define XB_TOP      3328
#define XB_TOPGEN   3392
#define XCD_BAR_WORDS 3456
#define XB_SPIN_CAP (1u << 18)

__device__ __forceinline__ unsigned xb_ld(unsigned* p)              { return __hip_atomic_load(p, __ATOMIC_RELAXED, __HIP_MEMORY_SCOPE_AGENT); }
__device__ __forceinline__ unsigned xb_add(unsigned* p, unsigned v) { return __hip_atomic_fetch_add(p, v, __ATOMIC_RELAXED, __HIP_MEMORY_SCOPE_AGENT); }
__device__ __forceinline__ unsigned xb_xcc_id() { return (unsigned)__builtin_amdgcn_s_getreg((3 << 11) | 20) & 0xFu; }
#define XB_SPIN(cond, bar) do { unsigned _sp = 0; while (cond) { __builtin_amdgcn_s_sleep(1); \
    if ((++_sp & 255u) == 0u) { if (xb_ld(&(bar)[XB_TMO])) break; if (_sp > XB_SPIN_CAP) { atomicAdd(&(bar)[XB_TMO], 1u); break; } } } } while (0)

struct XcdBarrier {
    unsigned* bar; unsigned x;
    volatile LAS unsigned* st;
};

__device__ __forceinline__ XcdBarrier xcd_barrier_post(unsigned* bar, volatile LAS unsigned* st) {
    XcdBarrier b; b.bar = bar; b.x = xb_xcc_id(); b.st = st;
    if (threadIdx.x == 0) (void)xb_add(&bar[XB_XCNT(b.x)], 1u);
    return b;
}
__device__ __forceinline__ void xcd_barrier_complete(unsigned* bar, unsigned x, unsigned& nloc, unsigned& nx) {
    const unsigned G = gridDim.x * gridDim.y * gridDim.z;
    unsigned sum, cnt, mine, sp = 0u;
    for (;;) {
        sum = 0u; cnt = 0u; mine = 0u;
#pragma unroll
        for (unsigned j = 0; j < 16; ++j) { const unsigned c = xb_ld(&bar[XB_XCNT(j)]); sum += c; cnt += (c > 0u) ? 1u : 0u; mine = (j == x) ? c : mine; }
        if (sum == G) break;
        __builtin_amdgcn_s_sleep(1);
        if ((++sp & 255u) == 0u) { if (xb_ld(&bar[XB_TMO])) break; if (sp > XB_SPIN_CAP) { atomicAdd(&bar[XB_TMO], 1u); break; } }
    }
    nloc = mine > 0u ? mine : 1u; nx = cnt > 0u ? cnt : 1u;
}

__device__ __forceinline__ void xcd_barrier(const XcdBarrier& b) {
    asm volatile("s_waitcnt vmcnt(0)" ::: "memory");
    __syncthreads();
    if (threadIdx.x == 0) {
        unsigned* bar = b.bar;
        __builtin_amdgcn_s_waitcnt(0);
        unsigned nloc = b.st[0], nx = b.st[1];
        if (nloc == 0u) { xcd_barrier_complete(bar, b.x, nloc, nx); b.st[0] = nloc; b.st[1] = nx; }
        const unsigned old = xb_add(&bar[XB_XSUB(b.x)], 1u);
        const unsigned gen = old / nloc;
        if (old + 1u == (gen + 1u) * nloc) {
            __builtin_amdgcn_fence(__ATOMIC_RELEASE, "agent");
            asm volatile("s_waitcnt vmcnt(0)" ::: "memory");
            const unsigned og = xb_add(&bar[XB_TOP], 1u);
            const unsigned tg = og / nx;
            if (og + 1u == (tg + 1u) * nx) xb_add(&bar[XB_TOPGEN], 1u);
            else XB_SPIN(xb_ld(&bar[XB_TOPGEN]) == tg, bar);
            __builtin_amdgcn_fence(__ATOMIC_ACQUIRE, "agent");
            xb_add(&bar[XB_XGEN(b.x)], 1u);
            asm volatile("s_waitcnt vmcnt(0)" ::: "memory");
        } else {
            XB_SPIN(xb_ld(&bar[XB_XGEN(b.x)]) == gen, bar);
            __builtin_amdgcn_fence(__ATOMIC_ACQUIRE, "agent");
            asm volatile("s_waitcnt vmcnt(0)" ::: "memory");
        }
    }
    __syncthreads();
}
constexpr int NWAVES = 8;
constexpr int NB = 8, SEQ = 2048, DM = 2048, T = NB * SEQ;
constexpr int AW = 1024, NH = 8, HD = 128, SW = 1024, NG = 64, GC = 16, NP = 64, INW = 4096;
constexpr int NE = 32, DFF = 2048, NREL = 257;
constexpr float EPS = 1e-5f;
#ifndef MK_N_LAUNCHES
#define MK_N_LAUNCHES 1
#endif
constexpr int NPH = 11;
constexpr int N_LAUNCHES = MK_N_LAUNCHES;

constexpr size_t MiB = 1u << 20;
constexpr size_t WS_CTL = 0, CTL_ZERO_BYTES = 1 * MiB;
constexpr size_t WS_ABAR = 1 * MiB;
constexpr size_t WS_TB = 1 * MiB + 64 * 1024;
constexpr size_t WS_TC = 1 * MiB + 64 * 1024 + 256 * 1024;
constexpr size_t WS_LIST = 2 * MiB;
constexpr size_t WS_TOKE = 4 * MiB, WS_TOKP = 4 * MiB + 256 * 1024, WS_TOKG = 4 * MiB + 512 * 1024;
constexpr size_t WS_WIN = 8 * MiB, WS_WGLU = 24 * MiB, WS_WOUT = 26 * MiB;
constexpr size_t WS_XN = 34 * MiB;
constexpr size_t WS_Q = 98 * MiB, WS_K = 130 * MiB, WS_V = 162 * MiB, WS_U = 194 * MiB;
constexpr size_t WS_AO = 226 * MiB, WS_G = 258 * MiB, WS_S = 290 * MiB;
constexpr size_t WS_MIX = 322 * MiB;
constexpr size_t WS_H1 = 386 * MiB;
constexpr size_t WS_WGU = 514 * MiB;
constexpr size_t WS_XN8 = 770 * MiB;
constexpr size_t WS_WD = 1026 * MiB;
constexpr size_t WS_Y = 1282 * MiB;
constexpr size_t WS_XG = 1570 * MiB;
constexpr size_t WS_HID = 1714 * MiB;
constexpr size_t WS_END = 1858 * MiB;
constexpr int CW_BAR = 4096, CW_CNT = 8192, CW_QUEUE = 12288, CW_P1DONE = 12288 + 128;

constexpr int RING_OFF = 0, RING_BYTES = 139264;
constexpr int MISC_OFF = RING_BYTES;
constexpr int LDS_BYTES = 147456;

typedef unsigned short bf16_t;
typedef unsigned v4u __attribute__((ext_vector_type(4)));
typedef unsigned v2u __attribute__((ext_vector_type(2)));
typedef float f32x4 __attribute__((ext_vector_type(4)));
typedef float f32x2 __attribute__((ext_vector_type(2)));
typedef float f32x16 __attribute__((ext_vector_type(16)));
typedef short bf16x8 __attribute__((ext_vector_type(8)));
#define LDS_WAIT() asm volatile("s_waitcnt lgkmcnt(0)" ::: "memory")
#define VM_WAIT() asm volatile("s_waitcnt vmcnt(0)" ::: "memory")
__device__ __forceinline__ unsigned f2bf(float f) { unsigned u = __builtin_bit_cast(unsigned, f); return (u + 0x7fffu + ((u >> 16) & 1u)) >> 16; }
__device__ __forceinline__ unsigned pk2(float lo, float hi) { return f2bf(lo) | (f2bf(hi) << 16); }
__device__ __forceinline__ float bflo(unsigned w) { return __uint_as_float(w << 16); }
__device__ __forceinline__ float bfhi(unsigned w) { return __uint_as_float(w & 0xffff0000u); }
__device__ __forceinline__ float wave_sum(float v) {
#pragma unroll
    for (int o = 1; o < 64; o <<= 1) v += __shfl_xor(v, o);
    return v;
}
__device__ __forceinline__ float gelu_tanh(float y) {
    const float z = 0.7978845608028654f * (y + 0.044715f * y * y * y);
    const float e = __expf(2.0f * z);
    const float th = 1.0f - 2.0f * __builtin_amdgcn_rcpf(e + 1.0f);
    return 0.5f * y * (1.0f + th);
}

struct Frame {
    LAS unsigned char* lds;
    volatile LAS unsigned* MISC;
    unsigned* ctl;
    int tid, lane, wave, G;
};

struct TrItem { const float* src; bf16_t* dst; int N, K; };
__device__ __forceinline__ bool p0_item_decode(const float* const* in, unsigned char* ws, long it, TrItem& t) {
    if (it < 4096) { const int kb = (int)it / 128, nb = (int)it % 128; t.N = INW; t.K = DM; t.src = in[2] + (size_t)(64 * kb) * INW + 32 * nb; t.dst = (bf16_t*)(ws + WS_WIN) + (size_t)(32 * nb) * DM + 64 * kb; return true; }
    it -= 4096;
    if (it < 512) { const int kb = (int)it / 32, nb = (int)it % 32; t.N = SW; t.K = SW; t.src = in[12] + (size_t)(64 * kb) * SW + 32 * nb; t.dst = (bf16_t*)(ws + WS_WGLU) + (size_t)(32 * nb) * SW + 64 * kb; return true; }
    it -= 512;
    if (it < 2048) { const int kb = (int)it / 64, nb = (int)it % 64; t.N = DM; t.K = DM; t.src = in[16] + (size_t)(64 * kb) * DM + 32 * nb; t.dst = (bf16_t*)(ws + WS_WOUT) + (size_t)(32 * nb) * DM + 64 * kb; return true; }
    it -= 2048;
    if (it < (long)NE * 3 * 2048) {
        const int e = (int)(it / 6144), r = (int)(it % 6144), which = r / 2048, q = r % 2048, kb = q / 64, nb = q % 64, n0 = 32 * nb;
        t.N = 2048; t.K = 2048;
        const float* W = which == 0 ? in[20] : (which == 1 ? in[22] : in[24]);
        t.src = W + (size_t)e * 2048 * 2048 + (size_t)(64 * kb) * 2048 + n0;
        if (which == 2) t.dst = (bf16_t*)(ws + WS_WD) + ((size_t)e * 2048 + n0) * 2048 + 64 * kb;
        else t.dst = (bf16_t*)(ws + WS_WGU) + ((size_t)e * 4096 + (size_t)(n0 >> 7) * 256 + (which == 1 ? 128 : 0) + (n0 & 127)) * 2048 + 64 * kb;
        return true;
    }
    return false;
}
constexpr long P0_NITEMS = 4096 + 512 + 2048 + (long)NE * 3 * 2048;
__device__ __forceinline__ void p0_item_load(const TrItem& t, int lane, f32x4 (&v)[8]) {
    const float* p = t.src + (size_t)(lane >> 3) * t.N + 4 * (lane & 7);
#pragma unroll
    for (int i = 0; i < 8; ++i) v[i] = *(const f32x4*)(p + (size_t)(8 * i) * t.N);
}
__device__ __forceinline__ void p0_item_store(const TrItem& t, int lane, const f32x4 (&v)[8], LAS float* scr) {
    const int kk = lane >> 3, n4 = 4 * (lane & 7);
#pragma unroll
    for (int i = 0; i < 8; ++i) { LAS float* s = scr + (kk + 8 * i) * 33 + n4; s[0] = v[i][0]; s[1] = v[i][1]; s[2] = v[i][2]; s[3] = v[i][3]; }
    LDS_WAIT();
    const int c = lane & 7;
#pragma unroll
    for (int j = 0; j < 4; ++j) { const int n = (lane >> 3) + 8 * j; const LAS float* s = scr + (8 * c) * 33 + n;
        v4u o; o.x = pg8::cvt_pk_bf16(s[0 * 33], s[1 * 33]); o.y = pg8::cvt_pk_bf16(s[2 * 33], s[3 * 33]); o.z = pg8::cvt_pk_bf16(s[4 * 33], s[5 * 33]); o.w = pg8::cvt_pk_bf16(s[6 * 33], s[7 * 33]);
        *(v4u*)(t.dst + (size_t)n * t.K + 8 * c) = o; }
    LDS_WAIT();
}
__device__ __forceinline__ void rms_row_to_bf16(const float* xrow, const float* gain, bf16_t* orow, int lane) {
    f32x4 v[8]; float s = 0.f;
#pragma unroll
    for (int j = 0; j < 8; ++j) { v[j] = *(const f32x4*)(xrow + 4 * (lane + 64 * j)); s += (v[j].x * v[j].x + v[j].y * v[j].y) + (v[j].z * v[j].z + v[j].w * v[j].w); }
    const float r = 1.0f / sqrtf(wave_sum(s) * (1.0f / DM) + EPS);
#pragma unroll
    for (int j = 0; j < 8; ++j) { const f32x4 g = *(const f32x4*)(gain + 4 * (lane + 64 * j));
        v2u o; o.x = pk2(v[j].x * r * g.x, v[j].y * r * g.y); o.y = pk2(v[j].z * r * g.z, v[j].w * r * g.w);
        *(v2u*)(orow + 4 * (lane + 64 * j)) = o; }
}
__device__ __forceinline__ void s5_disc(const float* const* in, int g, int p, double& are, double& aim, double& fre, double& fim) {
    const double dt = exp((double)in[6][g]); const double lr = (double)in[4][g * 64 + p], li = (double)in[5][g * 64 + p];
    const double mag = exp(lr * dt); are = mag * cos(li * dt); aim = mag * sin(li * dt);
    const double den = lr * lr + li * li, nr = are - 1.0, ni = aim;
    fre = (nr * lr + ni * li) / den; fim = (ni * lr - nr * li) / den;
}
__device__ __forceinline__ void conv_items(const float* const* in, unsigned char* ws, long it0, long step, int n, LAS float* scr, int lane) {
    if (n <= 0) return;
    TrItem t0, t1, t2, t3; f32x4 v0[8], v1[8], v2[8], v3[8];
#define CV_LOAD(T_, V_, idx) do { if ((idx) < n) { p0_item_decode(in, ws, it0 + (long)(idx) * step, T_); p0_item_load(T_, lane, V_); } } while (0)
#define CV_STORE(T_, V_, idx) do { if ((idx) < n) p0_item_store(T_, lane, V_, scr); } while (0)
    CV_LOAD(t0, v0, 0); CV_LOAD(t1, v1, 1); CV_LOAD(t2, v2, 2);
    for (int i = 0; i < n; i += 4) {
        CV_LOAD(t3, v3, i + 3); CV_STORE(t0, v0, i);
        CV_LOAD(t0, v0, i + 4); CV_STORE(t1, v1, i + 1);
        CV_LOAD(t1, v1, i + 5); CV_STORE(t2, v2, i + 2);
        CV_LOAD(t2, v2, i + 6); CV_STORE(t3, v3, i + 3);
    }
#undef CV_LOAD
#undef CV_STORE
}
constexpr int P0_SMALL_ITEMS = 4096 + 512 + 2048;
struct TrItem8 { const float* src; unsigned char* dst; };
__device__ __forceinline__ void p8_item_decode(const float* const* in, unsigned char* ws, int it, TrItem8& t) {
    const int e = it / 3072, r = it % 3072, which = r >> 10, q = r & 1023, kb = q >> 6, nb = q & 63, n0 = 32 * nb, k0 = 128 * kb;
    const float* W = which == 0 ? in[20] : (which == 1 ? in[22] : in[24]);
    t.src = W + (size_t)e * 2048 * 2048 + (size_t)k0 * 2048 + n0;
    if (which == 2) t.dst = ws + WS_WD + ((size_t)e * 2048 + n0) * 2048 + k0;
    else t.dst = ws + WS_WGU + ((size_t)e * 4096 + (size_t)(n0 >> 7) * 256 + (which == 1 ? 128 : 0) + (n0 & 127)) * 2048 + k0;
}
__device__ __forceinline__ void p8_item_load(const TrItem8& t, int lane, f32x4 (&v)[16]) {
    const float* p = t.src + (size_t)(4 * (lane >> 3)) * 2048 + 4 * (lane & 7);
#pragma unroll
    for (int i = 0; i < 4; ++i)
#pragma unroll
        for (int kq = 0; kq < 4; ++kq) v[4 * i + kq] = __builtin_nontemporal_load((const f32x4*)(p + (size_t)(32 * i + kq) * 2048));
}
__device__ __forceinline__ void p8_item_store(const TrItem8& t, int lane, const f32x4 (&v)[16], LAS unsigned* scr) {
    const int kb4 = lane >> 3, n4 = 4 * (lane & 7);
#pragma unroll
    for (int i = 0; i < 4; ++i)
#pragma unroll
        for (int q = 0; q < 4; ++q)
            scr[(n4 + q) * 33 + kb4 + 8 * i] = pg8::pk4_fp8(v[4 * i][q] * 32.0f, v[4 * i + 1][q] * 32.0f, v[4 * i + 2][q] * 32.0f, v[4 * i + 3][q] * 32.0f);
    LDS_WAIT();
    const int c = lane & 7;
#pragma unroll
    for (int j = 0; j < 4; ++j) { const int n = (lane >> 3) + 8 * j; const LAS unsigned* s = scr + n * 33 + 4 * c;
        v4u o; o.x = s[0]; o.y = s[1]; o.z = s[2]; o.w = s[3];
        __builtin_nontemporal_store(o, (v4u*)(t.dst + (size_t)n * 2048 + 16 * c)); }
    LDS_WAIT();
}
constexpr int CONV_UNIT_ITEMS = 64, N_CONV_UNITS = NE * 3 * 1024 / CONV_UNIT_ITEMS;
constexpr int CONV8_WAVE_BYTES = 32 * 33 * 4;
__device__ __forceinline__ void conv_unit8(const float* const* in, unsigned char* ws, int cu, int wave, int lane, LAS unsigned* scr) {
    TrItem8 ta, tb_; f32x4 va[16], vb[16];
    const int it0 = cu * CONV_UNIT_ITEMS + wave;
    p8_item_decode(in, ws, it0, ta); p8_item_load(ta, lane, va);
#pragma unroll 1
    for (int i = 0; i < CONV_UNIT_ITEMS / NWAVES; i += 2) {
        p8_item_decode(in, ws, it0 + 8 * (i + 1), tb_); p8_item_load(tb_, lane, vb);
        p8_item_store(ta, lane, va, scr);
        if (i + 2 < CONV_UNIT_ITEMS / NWAVES) { p8_item_decode(in, ws, it0 + 8 * (i + 2), ta); p8_item_load(ta, lane, va); }
        p8_item_store(tb_, lane, vb, scr);
    }
}
__device__ __forceinline__ void p0_prologue(Frame& F, const float* const* in, unsigned char* ws) {
    LAS float* scr = (LAS float*)(F.lds + RING_OFF + F.wave * 16384);
    const int gw = (int)blockIdx.x * NWAVES + F.wave, NGW = F.G * NWAVES;
    { const int n = gw < P0_SMALL_ITEMS ? (P0_SMALL_ITEMS - gw + NGW - 1) / NGW : 0; conv_items(in, ws, gw, NGW, n, scr, F.lane); }
    for (int m = gw; m < T; m += NGW) rms_row_to_bf16(in[0] + (size_t)m * DM, in[1], (bf16_t*)(ws + WS_XN) + (size_t)m * DM, F.lane);
    for (int it = gw; it < 64 + 256 + 256; it += NGW) {
        if (it < 64) { const int g = it, p = F.lane; double are, aim, fre, fim; s5_disc(in, g, p, are, aim, fre, fim);
            float* ab = (float*)(ws + WS_ABAR) + (g * 64 + p) * 2; ab[0] = (float)are; ab[1] = (float)aim; }
        else if (it < 320) { const int g = (it - 64) >> 2, cb = (it - 64) & 3, col = 32 * cb + (F.lane & 31), hi = F.lane >> 5, p = col & 63; const bool im = col >= 64;
            double are, aim, fre, fim; s5_disc(in, g, p, are, aim, fre, fim);
            unsigned w[4];
#pragma unroll
            for (int j2 = 0; j2 < 4; ++j2) { float o[2];
#pragma unroll
                for (int q = 0; q < 2; ++q) { const int c = 8 * hi + 2 * j2 + q; const double br = (double)in[7][(g * 64 + p) * 16 + c], bi = (double)in[8][(g * 64 + p) * 16 + c];
                    o[q] = (float)(im ? (fre * bi + fim * br) : (fre * br - fim * bi)); }
                w[j2] = pk2(o[0], o[1]); }
            *(v4u*)((bf16_t*)(ws + WS_TB) + ((size_t)(g * 4 + cb) * 64 + F.lane) * 8) = (v4u){w[0], w[1], w[2], w[3]}; }
        else { const int g = (it - 320) >> 2, kk = (it - 320) & 3, c = F.lane & 15, kq = F.lane >> 4;
            unsigned w[4];
#pragma unroll
            for (int j2 = 0; j2 < 4; ++j2) { float o[2];
#pragma unroll
                for (int q = 0; q < 2; ++q) { const int k = 32 * kk + 8 * kq + 2 * j2 + q;
                    o[q] = k < 64 ? in[9][(g * 16 + c) * 64 + k] : -in[10][(g * 16 + c) * 64 + (k - 64)]; }
                w[j2] = pk2(o[0], o[1]); }
            *(v4u*)((bf16_t*)(ws + WS_TC) + ((size_t)(g * 4 + kk) * 64 + F.lane) * 8) = (v4u){w[0], w[1], w[2], w[3]}; }
    }
}

constexpr int S5_ROWF = 132, S5_WAVE_BYTES = 32 * S5_ROWF * 4;
static_assert(NWAVES * S5_WAVE_BYTES <= RING_BYTES, "S5 scratch");
__device__ __forceinline__ void s5_sequence(int s, const bf16_t* U, bf16_t* Gout, const float* ABAR, const bf16_t* TB, const bf16_t* TC, const float* dvec, LAS unsigned char* ldsw, int lane) {
    const int b = s >> 6, g = s & 63, r32 = lane & 31, hi = lane >> 5, c16 = lane & 15, fq = lane >> 4;
    const bf16_t* Ub = U + (size_t)b * SEQ * SW + g * GC;
    bf16_t* Gb = Gout + (size_t)b * SEQ * SW + g * GC;
    bf16x8 bfr[4], cfr[4];
#pragma unroll
    for (int i = 0; i < 4; ++i) { bfr[i] = *(const bf16x8*)(TB + ((size_t)(g * 4 + i) * 64 + lane) * 8); cfr[i] = *(const bf16x8*)(TC + ((size_t)(g * 4 + i) * 64 + lane) * 8); }
    const float are = ABAR[(g * 64 + lane) * 2], aim = ABAR[(g * 64 + lane) * 2 + 1], dv = dvec[g * GC + c16];
    float hr = 0.f, hm = 0.f;
    LAS float* X = (LAS float*)ldsw;
    bf16x8 uf = *(const bf16x8*)(Ub + (size_t)r32 * SW + 8 * hi);
    for (int ci = 0; ci < SEQ / 32; ++ci) {
        const int t0 = 32 * ci;
        bf16x8 ufn = uf;
        if (ci + 1 < SEQ / 32) ufn = *(const bf16x8*)(Ub + (size_t)(t0 + 32 + r32) * SW + 8 * hi);
        bf16_t uq[2][4];
#pragma unroll
        for (int rb = 0; rb < 2; ++rb)
#pragma unroll
            for (int j = 0; j < 4; ++j) uq[rb][j] = Ub[(size_t)(t0 + 16 * rb + 4 * fq + j) * SW + c16];
#pragma unroll
        for (int cb = 0; cb < 4; ++cb) {
            f32x16 acc = {};
            acc = __builtin_amdgcn_mfma_f32_32x32x16_bf16(uf, bfr[cb], acc, 0, 0, 0);
#pragma unroll
            for (int r = 0; r < 16; ++r) X[((r & 3) + 8 * (r >> 2) + 4 * hi) * S5_ROWF + 32 * cb + r32] = acc[r];
        }
        LDS_WAIT(); __syncthreads();
#pragma unroll 8
        for (int t = 0; t < 32; ++t) {
            const float xr = X[t * S5_ROWF + lane], xi = X[t * S5_ROWF + 64 + lane];
            const float nr = are * hr - aim * hm + xr, ni = are * hm + aim * hr + xi;
            hr = nr; hm = ni;
            LAS bf16_t* hrow = (LAS bf16_t*)(X + t * S5_ROWF);
            hrow[lane] = (bf16_t)f2bf(hr); hrow[64 + lane] = (bf16_t)f2bf(hm);
        }
        LDS_WAIT(); __syncthreads();
#pragma unroll
        for (int rb = 0; rb < 2; ++rb) {
            f32x4 a4 = {0.f, 0.f, 0.f, 0.f};
#pragma unroll
            for (int kk = 0; kk < 4; ++kk) {
                const bf16x8 af = *(const LAS bf16x8*)((LAS unsigned char*)ldsw + (16 * rb + c16) * (S5_ROWF * 4) + (32 * kk + 8 * fq) * 2);
                a4 = __builtin_amdgcn_mfma_f32_16x16x32_bf16(af, cfr[kk], a4, 0, 0, 0);
            }
#pragma unroll
            for (int j = 0; j < 4; ++j) { const int t = t0 + 16 * rb + 4 * fq + j;
                const float uval = __uint_as_float((unsigned)uq[rb][j] << 16);
                const float y = a4[j] + dv * uval;
                Gb[(size_t)t * SW + c16] = (bf16_t)f2bf(gelu_tanh(y)); }
        }
        LDS_WAIT(); __syncthreads();
        uf = ufn;
    }
}

__device__ __forceinline__ void moe_tables(Frame& F) {
    __syncthreads();
    if (F.wave == 0) {
        unsigned c = 0;
        if (F.lane < NE) c = __hip_atomic_load(F.ctl + CW_CNT + 64 * F.lane, __ATOMIC_RELAXED, __HIP_MEMORY_SCOPE_AGENT);
        c = c > (unsigned)T ? (unsigned)T : c;
        int nt = (int)((c + 255u) >> 8), incl = nt;
#pragma unroll
        for (int o = 1; o < 32; o <<= 1) { const int v = __shfl_up(incl, o); if (F.lane >= o) incl += v; }
        if (F.lane < NE) F.MISC[25 + F.lane] = (unsigned)incl;
        if (F.lane == 0) F.MISC[24] = 0u;
    }
    __syncthreads();
}
struct Args { const float* in[27]; float* out; unsigned char* ws; int ph_lo, ph_hi, li, pad; };
__global__ void __launch_bounds__(NWAVES * 64, 2) mk_fwd(Args args) {
    extern __shared__ __attribute__((aligned(16))) unsigned char lds[];
    Frame F;
    F.lds = (LAS unsigned char*)lds;
    F.MISC = (volatile LAS unsigned*)(F.lds + MISC_OFF);
    F.tid = threadIdx.x; F.lane = F.tid & 63; F.wave = __builtin_amdgcn_readfirstlane(F.tid >> 6);
    F.G = gridDim.x;
    unsigned char* ws = args.ws;
    F.ctl = (unsigned*)(ws + WS_CTL);
    const float* const* in = args.in;
    for (int u = F.tid; u < (LDS_BYTES - MISC_OFF) / 4; u += NWAVES * 64) ((LAS unsigned*)(F.lds + MISC_OFF))[u] = 0u;
    __syncthreads();
    XcdBarrier bar; bar.bar = F.ctl + CW_BAR; bar.x = 0; bar.st = nullptr;
    if (N_LAUNCHES == 1) bar = xcd_barrier_post(F.ctl + CW_BAR, F.MISC + 8);
#define GRID_BAR() do { if (N_LAUNCHES == 1) xcd_barrier(bar); } while (0)
    const int lo = args.ph_lo, hi = args.ph_hi;
#define IN(k) (lo <= (k) && (k) < hi)
    const int gw = (int)blockIdx.x * NWAVES + F.wave, NGW = F.G * NWAVES;
    bf16_t* const XN = (bf16_t*)(ws + WS_XN);
    bf16_t* const Qb = (bf16_t*)(ws + WS_Q); bf16_t* const Kb = (bf16_t*)(ws + WS_K); bf16_t* const Vb = (bf16_t*)(ws + WS_V); bf16_t* const Ub = (bf16_t*)(ws + WS_U);
    bf16_t* const AO = (bf16_t*)(ws + WS_AO); bf16_t* const GB = (bf16_t*)(ws + WS_G); bf16_t* const SB = (bf16_t*)(ws + WS_S); bf16_t* const MIX = (bf16_t*)(ws + WS_MIX);
    bf16_t* const H1 = (bf16_t*)(ws + WS_H1);
    bf16_t* const XN2T = (bf16_t*)(ws + WS_XG);
    unsigned char* const HID8 = ws + WS_HID; unsigned char* const XN8 = ws + WS_XN8; unsigned char* const Y8 = ws + WS_Y;
    int* const LIST = (int*)(ws + WS_LIST); int* const TOKE = (int*)(ws + WS_TOKE); int* const TOKP = (int*)(ws + WS_TOKP); float* const TOKG = (float*)(ws + WS_TOKG);
    const LAS int* tb = (const LAS int*)(F.lds + MISC_OFF + 24 * 4);

    if (IN(0)) { p0_prologue(F, in, ws); GRID_BAR(); }

    if (IN(1)) {
#ifndef NCONV_WG_
#define NCONV_WG_ 48
#endif
        constexpr int NCONV_WG = NCONV_WG_;
        const int GG = (NCONV_WG > 0 && F.G > 2 * NCONV_WG) ? F.G - NCONV_WG : F.G;
        if ((int)blockIdx.x < GG) {
            pg8::Gemm g{XN, (const bf16_t*)(ws + WS_WIN), T, INW, DM}; pg8::StaticOrder S; S.init(T, INW, GG, (int)blockIdx.x);
            pg8::EpiBf16<0> E{Qb, AW, nullptr, AW, (size_t)(WS_K - WS_Q) / 2, 1.0f};
            pg8::gemm_phase<pg8::EpiBf16<0>, pg8::StaticOrder, true, true>(F.lds + RING_OFF, g, S, E);
            if (F.tid == 0) __hip_atomic_fetch_add(F.ctl + CW_P1DONE, 1u, __ATOMIC_RELAXED, __HIP_MEMORY_SCOPE_AGENT);
        } else {
            for (;;) {
                if (F.tid == 0) { const unsigned dn = __hip_atomic_load(F.ctl + CW_P1DONE, __ATOMIC_RELAXED, __HIP_MEMORY_SCOPE_AGENT);
                    F.MISC[16] = dn >= (unsigned)GG ? 0xffffffffu : __hip_atomic_fetch_add(F.ctl + CW_QUEUE, 1u, __ATOMIC_RELAXED, __HIP_MEMORY_SCOPE_AGENT); }
                __syncthreads();
                const unsigned cu = F.MISC[16];
                __syncthreads();
                if (cu >= (unsigned)N_CONV_UNITS) break;
                conv_unit8(in, ws, (int)cu, F.wave, F.lane, (LAS unsigned*)(F.lds + RING_OFF + F.wave * CONV8_WAVE_BYTES));
            }
        }
        GRID_BAR();
    }

    if (IN(2)) {
        constexpr int N_S5U = NB * NG / NWAVES, N_ATU = NB * NH * (SEQ / 256);
        if ((int)blockIdx.x < N_S5U)
            s5_sequence((int)blockIdx.x * NWAVES + F.wave, Ub, GB, (const float*)(ws + WS_ABAR), (const bf16_t*)(ws + WS_TB), (const bf16_t*)(ws + WS_TC), in[11],
                        F.lds + RING_OFF + F.wave * S5_WAVE_BYTES, F.lane);
        __syncthreads();
        if ((int)blockIdx.x >= N_S5U) {
            for (;;) {
                if (F.tid == 0) F.MISC[16] = __hip_atomic_fetch_add(F.ctl + CW_QUEUE, 1u, __ATOMIC_RELAXED, __HIP_MEMORY_SCOPE_AGENT);
                __syncthreads();
                const int cu = (int)F.MISC[16];
                __syncthreads();
                if (cu >= N_CONV_UNITS) break;
                conv_unit8(in, ws, (int)cu, F.wave, F.lane, (LAS unsigned*)(F.lds + RING_OFF + F.wave * CONV8_WAVE_BYTES));
            }
        }
        for (;;) {
            if (F.tid == 0) F.MISC[16] = __hip_atomic_fetch_add(F.ctl + CW_QUEUE + 64, 1u, __ATOMIC_RELAXED, __HIP_MEMORY_SCOPE_AGENT);
            __syncthreads();
            const int a = (int)F.MISC[16];
            __syncthreads();
            if (a >= N_ATU) break;
            const int qb = a & 7, h = (a >> 3) & 7, b = a >> 6;
            att::attn_unit(b, h, qb, (const att::bf16*)Qb, (const att::bf16*)Kb, (const att::bf16*)Vb, (att::bf16*)AO, in[3], (char*)lds + RING_OFF);
        }
        GRID_BAR();
    }

    if (IN(3)) {
        pg8::Gemm g{GB, (const bf16_t*)(ws + WS_WGLU), T, SW, SW}; pg8::StaticOrder S; S.init(T, SW, F.G, (int)blockIdx.x);
        pg8::EpiGlu E{GB, SB, SW, in[13]};
        pg8::gemm_phase<pg8::EpiGlu, pg8::StaticOrder, true, true>(F.lds + RING_OFF, g, S, E);
        GRID_BAR();
    }

    if (IN(4)) {
        for (int m = gw; m < T; m += NGW) {
#pragma unroll
            for (int half = 0; half < 2; ++half) {
                const bf16_t* src = (half ? SB : AO) + (size_t)m * AW; const float* gain = in[half ? 15 : 14];
                v4u w[2]; float s = 0.f;
#pragma unroll
                for (int j = 0; j < 2; ++j) { w[j] = *(const v4u*)(src + 8 * (F.lane + 64 * j));
#pragma unroll
                    for (int q = 0; q < 4; ++q) { const float a = bflo(w[j][q]), bq = bfhi(w[j][q]); s += a * a + bq * bq; } }
                const float r = 1.0f / sqrtf(wave_sum(s) * (1.0f / AW) + EPS);
#pragma unroll
                for (int j = 0; j < 2; ++j) { const int col = 8 * (F.lane + 64 * j); const f32x4 g0 = *(const f32x4*)(gain + col), g1 = *(const f32x4*)(gain + col + 4);
                    v4u o; o.x = pk2(bflo(w[j].x) * r * g0.x, bfhi(w[j].x) * r * g0.y); o.y = pk2(bflo(w[j].y) * r * g0.z, bfhi(w[j].y) * r * g0.w);
                    o.z = pk2(bflo(w[j].z) * r * g1.x, bfhi(w[j].z) * r * g1.y); o.w = pk2(bflo(w[j].w) * r * g1.z, bfhi(w[j].w) * r * g1.w);
                    *(v4u*)(MIX + (size_t)m * DM + half * AW + col) = o; }
            }
        }
        GRID_BAR();
    }

    if (IN(5)) {
        pg8::Gemm g{MIX, (const bf16_t*)(ws + WS_WOUT), T, DM, DM}; pg8::StaticOrder S; S.init(T, DM, F.G, (int)blockIdx.x);
        pg8::EpiResBf16 E{in[0], H1, DM};
        pg8::gemm_phase<pg8::EpiResBf16, pg8::StaticOrder, true, true>(F.lds + RING_OFF, g, S, E);
        GRID_BAR();
    }

    if (IN(6)) {
        constexpr int N2S = 2052;
        LAS float* n2s = (LAS float*)(F.lds + RING_OFF);
        static_assert(16 * N2S * 4 <= RING_BYTES, "router tile");
        for (int pass = (int)blockIdx.x; pass < T / 16; pass += F.G) {
#pragma unroll 1
            for (int rr = 0; rr < 2; ++rr) {
                const int lr = 2 * F.wave + rr, row = 16 * pass + lr;
                const bf16_t* xrow = H1 + (size_t)row * DM;
                f32x4 v[8]; float s = 0.f;
#pragma unroll
                for (int j = 0; j < 8; ++j) { const v2u w = *(const v2u*)(xrow + 4 * (F.lane + 64 * j)); v[j] = (f32x4){bflo(w.x), bfhi(w.x), bflo(w.y), bfhi(w.y)};
                    s += (v[j].x * v[j].x + v[j].y * v[j].y) + (v[j].z * v[j].z + v[j].w * v[j].w); }
                const float r = 1.0f / sqrtf(wave_sum(s) * (1.0f / DM) + EPS);
#pragma unroll
                for (int j = 0; j < 8; ++j) { const int col = 4 * (F.lane + 64 * j); const f32x4 g = *(const f32x4*)(in[17] + col);
                    const f32x4 n = {v[j].x * r * g.x, v[j].y * r * g.y, v[j].z * r * g.z, v[j].w * r * g.w};
                    *(LAS f32x4*)(n2s + lr * N2S + col) = n;
                    *(unsigned*)(XN8 + (size_t)row * DM + col) = pg8::pk4_fp8(n.x, n.y, n.z, n.w); }
            }
            __syncthreads();
            f32x4 lg0 = {0.f, 0.f, 0.f, 0.f}, lg1 = {0.f, 0.f, 0.f, 0.f};
            {
                const int c16 = F.lane & 15, kq = F.lane >> 4;
                const LAS float* ap = n2s + c16 * N2S + 256 * F.wave + kq;
                const float* bp = in[18] + (size_t)(256 * F.wave + kq) * NE + c16;
#pragma unroll 8
                for (int s4 = 0; s4 < 64; ++s4) {
                    const float av = ap[4 * s4]; const float b0 = bp[(size_t)(4 * s4) * NE], b1 = bp[(size_t)(4 * s4) * NE + 16];
                    lg0 = __builtin_amdgcn_mfma_f32_16x16x4f32(av, b0, lg0, 0, 0, 0);
                    lg1 = __builtin_amdgcn_mfma_f32_16x16x4f32(av, b1, lg1, 0, 0, 0);
                }
            }
            __syncthreads();
            {
                const int c16 = F.lane & 15, tq = F.lane >> 4;
#pragma unroll
                for (int j = 0; j < 4; ++j) { n2s[(F.wave * 16 + 4 * tq + j) * 32 + c16] = lg0[j]; n2s[(F.wave * 16 + 4 * tq + j) * 32 + 16 + c16] = lg1[j]; }
            }
            __syncthreads();
            {
                const int tl = F.tid >> 5, e = F.tid & 31, token = 16 * pass + tl;
                float val = in[19][e];
#pragma unroll
                for (int w = 0; w < NWAVES; ++w) val += n2s[(w * 16 + tl) * 32 + e];
                float tv0 = 0.f, tv1 = 0.f, tv2 = 0.f, tv3 = 0.f; int ti0 = 0, ti1 = 0, ti2 = 0, ti3 = 0;
#pragma unroll
                for (int k = 0; k < 4; ++k) {
                    float bv = val; int bi = e;
#pragma unroll
                    for (int off = 16; off >= 1; off >>= 1) { const float ov = __shfl_xor(bv, off); const int oi = __shfl_xor(bi, off); if (ov > bv || (ov == bv && oi < bi)) { bv = ov; bi = oi; } }
                    if (k == 0) { tv0 = bv; ti0 = bi; } else if (k == 1) { tv1 = bv; ti1 = bi; } else if (k == 2) { tv2 = bv; ti2 = bi; } else { tv3 = bv; ti3 = bi; }
                    if (e == bi) val = -INFINITY;
                }
                const float e0 = 1.0f, e1 = __expf(tv1 - tv0), e2 = __expf(tv2 - tv0), e3 = __expf(tv3 - tv0), inv = 1.0f / (e0 + e1 + e2 + e3);
                if (e < 4) {
                    const int ek = e == 0 ? ti0 : (e == 1 ? ti1 : (e == 2 ? ti2 : ti3));
                    const float gk = (e == 0 ? e0 : (e == 1 ? e1 : (e == 2 ? e2 : e3))) * inv;
                    const unsigned pos = __hip_atomic_fetch_add(F.ctl + CW_CNT + 64 * ek, 1u, __ATOMIC_RELAXED, __HIP_MEMORY_SCOPE_AGENT);
                    if (pos < (unsigned)T) LIST[(size_t)ek * T + pos] = token;
                    TOKE[token * 4 + e] = ek; TOKP[token * 4 + e] = (int)pos; TOKG[token * 4 + e] = gk;
                }
            }
            __syncthreads();
        }
        GRID_BAR();
    }

    if (IN(8)) {
        moe_tables(F);
        pg8::Gemm g{(const bf16_t*)XN8, (const bf16_t*)(ws + WS_WGU), 0, 0, DM / 2, LIST, tb, 4, T}; pg8::MoeOrder S{tb, 16, F.G, (int)blockIdx.x};
        pg8::EpiSwiglu8 E{HID8, DFF, in[21], in[23]};
        pg8::gemm_phase<pg8::EpiSwiglu8, pg8::MoeOrder, true, true, true, true>(F.lds + RING_OFF, g, S, E);
        GRID_BAR();
    }

    if (IN(9)) {
        moe_tables(F);
        pg8::Gemm g{(const bf16_t*)HID8, (const bf16_t*)(ws + WS_WD), 0, 0, DFF / 2}; pg8::MoeOrder S{tb, 8, F.G, (int)blockIdx.x};
        pg8::EpiFp8 E{Y8, DM, in[25], DM};
        pg8::gemm_phase<pg8::EpiFp8, pg8::MoeOrder, true, true, true>(F.lds + RING_OFF, g, S, E);
        GRID_BAR();
    }

    if (IN(10)) {
        moe_tables(F);
        for (int m = gw; m < T; m += NGW) {
            f32x4 v[8];
#pragma unroll
            for (int j = 0; j < 8; ++j) { const v2u w = *(const v2u*)(H1 + (size_t)m * DM + 4 * (F.lane + 64 * j)); v[j] = (f32x4){bflo(w.x), bfhi(w.x), bflo(w.y), bfhi(w.y)}; }
#pragma unroll
            for (int k = 0; k < 4; ++k) { const int ek = TOKE[m * 4 + k], pk = TOKP[m * 4 + k]; const float gk = TOKG[m * 4 + k]; const unsigned char* y = Y8 + ((size_t)tb[ek] * 256 + pk) * DM;
#pragma unroll
                for (int j = 0; j < 8; ++j) { const unsigned w = *(const unsigned*)(y + 4 * (F.lane + 64 * j));
                    const f32x2 lo = __builtin_amdgcn_cvt_pk_f32_fp8((int)w, false), hi2 = __builtin_amdgcn_cvt_pk_f32_fp8((int)w, true);
                    v[j].x += gk * lo[0]; v[j].y += gk * lo[1]; v[j].z += gk * hi2[0]; v[j].w += gk * hi2[1]; } }
            float s = 0.f;
#pragma unroll
            for (int j = 0; j < 8; ++j) s += (v[j].x * v[j].x + v[j].y * v[j].y) + (v[j].z * v[j].z + v[j].w * v[j].w);
            const float r = 1.0f / sqrtf(wave_sum(s) * (1.0f / DM) + EPS);
#pragma unroll
            for (int j = 0; j < 8; ++j) { const int col = 4 * (F.lane + 64 * j); const f32x4 g = *(const f32x4*)(in[26] + col);
                *(f32x4*)(args.out + (size_t)m * DM + col) = (f32x4){v[j].x * r * g.x, v[j].y * r * g.y, v[j].z * r * g.z, v[j].w * r * g.w}; }
        }
    }
#undef IN
#undef GRID_BAR
}

extern "C" void kernel_launch(void* const* d_in, const int* in_sizes, int n_in, void* d_out, int out_size, void* d_ws, size_t ws_size, hipStream_t stream) {
    static int grid = 0;
    if (grid == 0) {
        if (n_in != 27 || in_sizes[0] != T * DM || out_size != T * DM || ws_size < WS_END) {
            fprintf(stderr, "kernel_launch: shape/workspace mismatch: n_in %d in0 %d out %d ws %zu (need %zu); nothing launched\n", n_in, n_in > 0 ? in_sizes[0] : -1, out_size, ws_size, (size_t)WS_END); grid = -1; return; }
        int dev = 0, cus = 0, per_cu = 0;
        if (hipGetDevice(&dev) != hipSuccess || hipDeviceGetAttribute(&cus, hipDeviceAttributeMultiprocessorCount, dev) != hipSuccess) { fprintf(stderr, "kernel_launch: device query failed\n"); grid = -1; return; }
        if (hipFuncSetAttribute((const void*)mk_fwd, hipFuncAttributeMaxDynamicSharedMemorySize, LDS_BYTES) != hipSuccess) { fprintf(stderr, "kernel_launch: hipFuncSetAttribute failed\n"); grid = -1; return; }
        if (hipOccupancyMaxActiveBlocksPerMultiprocessor(&per_cu, (const void*)mk_fwd, NWAVES * 64, LDS_BYTES) != hipSuccess || per_cu < 1)
            fprintf(stderr, "kernel_launch: note: occupancy query reports %d workgroups per CU\n", per_cu);
        (void)hipGetLastError();
        grid = cus;
    }
    if (grid < 0) return;
    if (hipMemsetAsync((char*)d_ws + WS_CTL, 0, CTL_ZERO_BYTES, stream) != hipSuccess) { fprintf(stderr, "kernel_launch: memset failed\n"); return; }
    Args a{};
    for (int i = 0; i < 27; ++i) a.in[i] = (const float*)d_in[i];
    a.out = (float*)d_out; a.ws = (unsigned char*)d_ws; a.pad = 0;
    for (int li = 0; li < N_LAUNCHES; ++li) {
        a.ph_lo = (N_LAUNCHES == 1) ? 0 : li; a.ph_hi = (N_LAUNCHES == 1) ? NPH : li + 1; a.li = li;
        hipLaunchKernelGGL(mk_fwd, dim3(grid), dim3(NWAVES * 64), LDS_BYTES, stream, a);
        const hipError_t le = hipPeekAtLastError();
        if (le != hipSuccess) { fprintf(stderr, "kernel_launch: launch %d failed: %s\n", li, hipGetErrorName(le)); break; }
    }
}
```

```cpp
#include <hip/hip_runtime.h>
#include <hip/hip_bf16.h>
#include <cstdio>
#include <cstdint>
#include <cmath>
namespace pg8 {
#define PG8_LAS __attribute__((address_space(3)))
typedef unsigned short bf16_t;
typedef short bf16x8 __attribute__((ext_vector_type(8)));
typedef float f32x4 __attribute__((ext_vector_type(4)));
typedef unsigned u32x4 __attribute__((ext_vector_type(4)));
constexpr int BM = 256, BK = 64, HALF = 128, HTB = HALF * BK * 2  , STAGE_BYTES = 8 * HTB, NXCD = 8, WGM = 8;

__host__ __device__ __forceinline__ int lds_byte(int r, int c) { const int st = (r >> 4) * 2 + (c >> 5), rr = r & 15, cc = c & 31, ob = rr * 64 + cc * 2; return st * 1024 + (ob ^ (((ob >> 9) & 1) << 5)); }
__host__ __device__ __forceinline__ void stage_rc(int b, int& R, int& C) { const int st = b / 1024, sb = b % 1024, swz = sb ^ (((sb >> 9) & 1) << 5); R = (st >> 1) * 16 + swz / 64; C = (st & 1) * 32 + (swz % 64) / 2; }
__host__ __device__ __forceinline__ int perm32(int rho) { const int n = rho >> 4, i = rho & 15; return 8 * (i >> 2) + 4 * n + (i & 3); }

struct Unit { int pm, pn; };
struct Gemm { const bf16_t* A; const bf16_t* Bt; int M, N, K;
    const int* glist = nullptr; const PG8_LAS int* gtb = nullptr; int gshift = 0, gT = 0; };

struct StaticOrder {
    int nM, nN, nwg, G, c;
    __host__ __device__ void init(int M, int N, int G_, int c_) { nM = M / BM; nN = N / BM; nwg = nM * nN; G = G_; c = c_; }
    __host__ __device__ bool next(int i, Unit& u) const {
        const long L = (long)i * G + c; if (L >= nwg) return false;
        int wgid = (int)L; { const int q = nwg / NXCD, r = nwg % NXCD, xcd = wgid % NXCD, off = wgid / NXCD; wgid = (xcd < r ? xcd * (q + 1) : r * (q + 1) + (xcd - r) * q) + off; }
        const int nig = WGM * nN, gid = wgid / nig, fm = gid * WGM, gsz = (nM - fm) < WGM ? (nM - fm) : WGM;
        u.pm = fm + ((wgid % nig) % gsz); u.pn = (wgid % nig) / gsz; return true;
    }
    __device__ __forceinline__ void a_ready(const Unit&) const {}
    __device__ __forceinline__ void done(const Unit&) const {}
};

__device__ __forceinline__ unsigned cvt_pk_bf16(float lo, float hi) { unsigned r; asm volatile("v_cvt_pk_bf16_f32 %0, %1, %2" : "=v"(r) : "v"(lo), "v"(hi)); return r; }
typedef float f32x2 __attribute__((ext_vector_type(2)));
__device__ __forceinline__ f32x2 gelu_pk(f32x2 v) {
    const f32x2 av = __builtin_elementwise_abs(v), d = av * 0.2316418882f + 1.0f;
    f32x2 t; t.x = __builtin_amdgcn_rcpf(d.x); t.y = __builtin_amdgcn_rcpf(d.y);
    f32x2 q = t * 0.5307027145f + (-0.7265760135f); q = q * t + 0.7107068705f; q = q * t + (-0.142248368f); q = q * t + 0.127414796f; q = q * t;
    const f32x2 s = (v * v) * (-0.72134752044f);
    f32x2 e; e.x = __builtin_amdgcn_exp2f(s.x); e.y = __builtin_amdgcn_exp2f(s.y);
    const f32x2 m = v * (q * e), r = v - m;
    f32x2 o; o.x = v.x < 0.f ? m.x : r.x; o.y = v.y < 0.f ? m.y : r.y; return o;
}

template <int ACT  > struct EpiBf16 {
    static constexpr bool PERM = true, AFTER_DRAIN = false; static_assert(ACT == 0 || ACT == 1, "EpiBf16: ACT is 0 (none) or 1 (gelu_pk)");
    bf16_t* O; int ldc; const float* bias; int split_cols; size_t split_stride; float scale0;
    __device__ __forceinline__ void operator()(const f32x4 (&acc)[2][2][4][2], const Unit& u, int wr, int wc, int fr, int fq) const {
        const int row0 = u.pm * BM + wr * 64 + fr; int colt = u.pn * BM; bf16_t* base = O;
        float sc = 1.f; if (split_cols) { const int t = colt / split_cols; base += (size_t)t * split_stride; colt -= t * split_cols; if (t == 0) sc = scale0; }
        const int col0 = colt + wc * 32 + 8 * fq, bcol0 = u.pn * BM + wc * 32 + 8 * fq;
        f32x4 bv[2][2];
#pragma unroll
        for (int bj = 0; bj < 2; ++bj)
#pragma unroll
            for (int n = 0; n < 2; ++n) bv[bj][n] = bias ? *(const f32x4*)(bias + bcol0 + bj * HALF + 4 * n) : (f32x4){0.f, 0.f, 0.f, 0.f};
#pragma unroll
        for (int ai = 0; ai < 2; ++ai)
#pragma unroll
            for (int m = 0; m < 4; ++m) { bf16_t* rowp = base + (size_t)(row0 + ai * HALF + m * 16) * ldc + col0;
#pragma unroll
                for (int bj = 0; bj < 2; ++bj) { f32x4 v0 = acc[ai][bj][m][0] + bv[bj][0], v1 = acc[ai][bj][m][1] + bv[bj][1];
                    if (ACT == 1) { f32x2 a = gelu_pk((f32x2){v0[0], v0[1]}), b = gelu_pk((f32x2){v0[2], v0[3]}), c = gelu_pk((f32x2){v1[0], v1[1]}), d = gelu_pk((f32x2){v1[2], v1[3]});
                        v0 = (f32x4){a.x, a.y, b.x, b.y}; v1 = (f32x4){c.x, c.y, d.x, d.y}; }
                    v0 = v0 * sc; v1 = v1 * sc; u32x4 w; w.x = cvt_pk_bf16(v0[0], v0[1]); w.y = cvt_pk_bf16(v0[2], v0[3]); w.z = cvt_pk_bf16(v1[0], v1[1]); w.w = cvt_pk_bf16(v1[2], v1[3]);
                    *(u32x4*)(rowp + bj * HALF) = w; } }
    }
};
typedef int v8i_t __attribute__((ext_vector_type(8)));
typedef int v4i_t __attribute__((ext_vector_type(4)));
__device__ __forceinline__ v8i_t cat8(bf16x8 a, bf16x8 b) { const v4i_t x = __builtin_bit_cast(v4i_t, a), y = __builtin_bit_cast(v4i_t, b); return (v8i_t){x[0], x[1], x[2], x[3], y[0], y[1], y[2], y[3]}; }
__device__ __forceinline__ void mfma8_inplace(f32x4& c, v8i_t a, v8i_t b, int sa, int sb) {
    asm volatile("v_mfma_scale_f32_16x16x128_f8f6f4 %0, %1, %2, %0, %3, %4 op_sel_hi:[0,0,0]" : "+v"(c) : "v"(a), "v"(b), "v"(sa), "v"(sb)); }
template <class Epi, class Sched, bool ALIGN_EPI = false, bool SP2 = false, bool FP8 = false, bool GATHER = false>
__device__ __forceinline__ void gemm_phase(PG8_LAS unsigned char* lds, const Gemm g, const Sched& S, const Epi& E) {
    const int tid = threadIdx.x, wid = __builtin_amdgcn_readfirstlane(tid >> 6), lane = tid & 63, wr = wid >> 2, wc = wid & 3, fr = lane & 15, fq = lane >> 4;
    const int K = g.K, nt = K / BK;
    int sc_w = 0x7a7a7a7a, sc_a = 0x7f7f7f7f; if constexpr (FP8) { asm volatile("" : "+v"(sc_w), "+v"(sc_a)); }
    unsigned voffA[2], voffB[2]; int Ri[2]; unsigned Cb[2];
#pragma unroll
    for (int i = 0; i < 2; ++i) { int R, C; stage_rc(tid * 16 + i * 8192, R, C); const int Rb = Epi::PERM ? ((R & ~31) + perm32(R & 31)) : R;
        voffA[i] = (unsigned)(R * K + C) * 2u; voffB[i] = (unsigned)(Rb * K + C) * 2u; Ri[i] = R; Cb[i] = (unsigned)C * 2u; }
    unsigned gc[2][2] = {{0u, 0u}, {0u, 0u}}, gn[2][2] = {{0u, 0u}, {0u, 0u}}; int tkn[2][2] = {{0, 0}, {0, 0}};
    const size_t kstep = (size_t)(BK * 2);
    const size_t hstep = (size_t)HALF * K * 2;
    const size_t tstep = 2 * hstep;
    const unsigned ldsw = (unsigned)wid * 1024u;
    const int aoff = lds_byte(wr * 64 + fr, fq * 8), boff = lds_byte(wc * 32 + fr, fq * 8);
#define PG8_SA(b, h) (((b) * 2 + (h)) * HTB)
#define PG8_SB(b, h) ((4 + (b) * 2 + (h)) * HTB)
#define PG8_STAGE(bufoff, gbase, voff) do { _Pragma("unroll") for (int _i = 0; _i < 2; ++_i) \
        __builtin_amdgcn_global_load_lds((const unsigned*)((const char*)(gbase) + (voff)[_i]), (PG8_LAS unsigned*)(lds + (bufoff) + ldsw + _i * 8192), 16, 0, 0); } while (0)
#define PG8_TOK(u, tk) do { const int e_ = (u).pn >> g.gshift; const int* lp_ = g.glist + (size_t)e_ * g.gT + ((u).pm - g.gtb[e_]) * BM; \
        _Pragma("unroll") for (int h_ = 0; h_ < 2; ++h_) _Pragma("unroll") for (int i_ = 0; i_ < 2; ++i_) tk[h_][i_] = lp_[h_ * HALF + Ri[i_]]; } while (0)
#define PG8_GOFF(tk, go) do { _Pragma("unroll") for (int h_ = 0; h_ < 2; ++h_) _Pragma("unroll") for (int i_ = 0; i_ < 2; ++i_) { const int t_ = (unsigned)tk[h_][i_] < (unsigned)g.gT ? tk[h_][i_] : 0; \
        go[h_][i_] = (unsigned)t_ * (unsigned)(K * 2) + Cb[i_]; } } while (0)
#define PG8_STAGE_A(bufoff, ptr, h, nx) do { if constexpr (GATHER) { unsigned vo_[2]; vo_[0] = (nx) ? gn[h][0] : gc[h][0]; vo_[1] = (nx) ? gn[h][1] : gc[h][1]; PG8_STAGE(bufoff, ptr, vo_); } \
        else { PG8_STAGE(bufoff, (ptr) + ((h) ? hstep : (size_t)0), voffA); } } while (0)
#define PG8_LDA(dst, b, h) do { _Pragma("unroll") for (int m = 0; m < 4; ++m) _Pragma("unroll") for (int k = 0; k < 2; ++k) dst[m][k] = *(const PG8_LAS bf16x8*)(lds + PG8_SA(b, h) + aoff + m * 2048 + k * 1024); } while (0)
#define PG8_LDB(dst, b, h) do { _Pragma("unroll") for (int n = 0; n < 2; ++n) _Pragma("unroll") for (int k = 0; k < 2; ++k) dst[n][k] = *(const PG8_LAS bf16x8*)(lds + PG8_SB(b, h) + boff + n * 2048 + k * 1024); } while (0)
#define PG8_MMA(ai, bj, At, Bt) do { __builtin_amdgcn_s_setprio(1); if constexpr (FP8) { _Pragma("unroll") for (int m = 0; m < 4; ++m) _Pragma("unroll") for (int n = 0; n < 2; ++n) \
        mfma8_inplace(acc[ai][bj][m][n], cat8(Bt[n][0], Bt[n][1]), cat8(At[m][0], At[m][1]), sc_w, sc_a); } else { \
        _Pragma("unroll") for (int m = 0; m < 4; ++m) _Pragma("unroll") for (int n = 0; n < 2; ++n) _Pragma("unroll") for (int k = 0; k < 2; ++k) \
        acc[ai][bj][m][n] = __builtin_amdgcn_mfma_f32_16x16x32_bf16(Bt[n][k], At[m][k], acc[ai][bj][m][n], 0, 0, 0); } __builtin_amdgcn_s_setprio(0); } while (0)
#define PG8_WAIT_V(n) asm volatile("s_waitcnt vmcnt(" #n ")" ::: "memory")
#define PG8_WAIT_L(n) asm volatile("s_waitcnt lgkmcnt(" #n ")" ::: "memory")
#define PG8_BAR __builtin_amdgcn_s_barrier()
#define PG8_SCHED __builtin_amdgcn_sched_barrier(0)
    Unit cur, nxt; int ui = 0;
    if (!S.next(0, cur)) return;
    f32x4 acc[2][2][4][2];
#pragma unroll
    for (int a = 0; a < 2; ++a)
#pragma unroll
        for (int b = 0; b < 2; ++b)
#pragma unroll
            for (int m = 0; m < 4; ++m)
#pragma unroll
                for (int n = 0; n < 2; ++n) acc[a][b][m][n] = (f32x4){0.f, 0.f, 0.f, 0.f};
    bf16x8 At[4][2], B0[2][2], B1[2][2];
    const char* cA = (const char*)g.A + (GATHER ? (size_t)0 : (size_t)cur.pm * tstep); const char* cB = (const char*)g.Bt + (size_t)cur.pn * tstep;
    if constexpr (GATHER) { PG8_TOK(cur, tkn); PG8_GOFF(tkn, gc); Unit n1_; if (S.next(1, n1_)) PG8_TOK(n1_, tkn); }
    S.a_ready(cur);
    if constexpr (SP2) {
        PG8_STAGE(PG8_SB(0, 0), cB, voffB); PG8_STAGE(PG8_SB(0, 1), cB + hstep, voffB); PG8_STAGE_A(PG8_SA(0, 0), cA, 0, false); PG8_STAGE_A(PG8_SA(0, 1), cA, 1, false);
        if (wr == 1) PG8_BAR;
        PG8_WAIT_V(2); PG8_BAR;
        PG8_STAGE(PG8_SB(1, 0), cB + kstep, voffB); PG8_STAGE_A(PG8_SA(1, 0), cA + kstep, 0, false); PG8_STAGE(PG8_SB(1, 1), cB + hstep + kstep, voffB);
        PG8_WAIT_V(6); PG8_BAR;
    } else {
        PG8_STAGE(PG8_SB(0, 0), cB, voffB); PG8_STAGE_A(PG8_SA(0, 0), cA, 0, false); PG8_STAGE(PG8_SB(0, 1), cB + hstep, voffB); PG8_STAGE_A(PG8_SA(0, 1), cA, 1, false);
        if (wr == 1) PG8_BAR;
        PG8_WAIT_V(4); PG8_BAR;
        PG8_STAGE(PG8_SB(1, 0), cB + kstep, voffB); PG8_STAGE_A(PG8_SA(1, 0), cA + kstep, 0, false); PG8_STAGE(PG8_SB(1, 1), cB + hstep + kstep, voffB);
        PG8_WAIT_V(6); PG8_BAR;
    }
    for (;;) {
        const bool has_next = S.next(ui + 1, nxt);
        const char* nA = (has_next && !GATHER) ? (const char*)g.A + (size_t)nxt.pm * tstep : cA; const char* nB = has_next ? (const char*)g.Bt + (size_t)nxt.pn * tstep : cB;
        if constexpr (GATHER) { if (has_next) { PG8_GOFF(tkn, gn); } else { gn[0][0] = gc[0][0]; gn[0][1] = gc[0][1]; gn[1][0] = gc[1][0]; gn[1][1] = gc[1][1]; }
            Unit n2_; if (S.next(ui + 2, n2_)) PG8_TOK(n2_, tkn); }
        for (int t = 0; t < nt; t += 2) {
            const bool last = (t == nt - 2);
            const char* a1 = cA + (size_t)(t + 1) * kstep;
            const char* a2 = last ? nA : cA + (size_t)(t + 2) * kstep; const char* b2 = last ? nB : cB + (size_t)(t + 2) * kstep;
            const char* a3 = a2 + kstep; const char* b3 = b2 + kstep;
            if (last && has_next) S.a_ready(nxt);
            if constexpr (SP2) {
            PG8_LDB(B0, 0, 0); PG8_LDB(B1, 0, 1); PG8_SCHED; PG8_LDA(At, 0, 0); PG8_STAGE_A(PG8_SA(1, 1), a1, 1, false);
            PG8_WAIT_V(8); PG8_WAIT_L(0); PG8_BAR; PG8_MMA(0, 0, At, B0); PG8_MMA(0, 1, At, B1); PG8_BAR; PG8_SCHED;
            PG8_LDA(At, 0, 1); PG8_STAGE(PG8_SB(0, 0), b2, voffB); PG8_STAGE(PG8_SB(0, 1), b2 + hstep, voffB); PG8_STAGE_A(PG8_SA(0, 0), a2, 0, last);
            PG8_WAIT_V(8); PG8_WAIT_L(0); PG8_BAR; PG8_MMA(1, 0, At, B0); PG8_MMA(1, 1, At, B1); PG8_BAR; PG8_SCHED;
            PG8_LDB(B0, 1, 0); PG8_LDB(B1, 1, 1); PG8_SCHED; PG8_LDA(At, 1, 0); PG8_STAGE_A(PG8_SA(0, 1), a2, 1, last);
            PG8_WAIT_V(8); PG8_WAIT_L(0); PG8_BAR; PG8_MMA(0, 0, At, B0); PG8_MMA(0, 1, At, B1); PG8_BAR; PG8_SCHED;
            PG8_LDA(At, 1, 1); PG8_STAGE(PG8_SB(1, 0), b3, voffB); PG8_STAGE(PG8_SB(1, 1), b3 + hstep, voffB); PG8_STAGE_A(PG8_SA(1, 0), a3, 0, last);
            PG8_WAIT_V(8); PG8_WAIT_L(0); PG8_BAR; PG8_MMA(1, 0, At, B0); PG8_MMA(1, 1, At, B1); PG8_BAR; PG8_SCHED;
            } else {
            PG8_LDB(B0, 0, 0); PG8_SCHED; PG8_LDA(At, 0, 0); PG8_STAGE_A(PG8_SA(1, 1), a1, 1, false);
            PG8_WAIT_L(8); PG8_BAR; PG8_WAIT_L(0); PG8_MMA(0, 0, At, B0); PG8_BAR; PG8_SCHED;
            PG8_LDB(B1, 0, 1); PG8_STAGE(PG8_SB(0, 0), b2, voffB);
            PG8_BAR; PG8_WAIT_L(0); PG8_MMA(0, 1, At, B1); PG8_BAR;
            PG8_LDA(At, 0, 1); PG8_STAGE_A(PG8_SA(0, 0), a2, 0, last);
            PG8_BAR; PG8_WAIT_L(0); PG8_MMA(1, 0, At, B0); PG8_BAR; PG8_SCHED;
            PG8_STAGE(PG8_SB(0, 1), b2 + hstep, voffB);
            PG8_WAIT_V(6); PG8_BAR; PG8_MMA(1, 1, At, B1); PG8_BAR;
            PG8_LDB(B0, 1, 0); PG8_SCHED; PG8_LDA(At, 1, 0); PG8_STAGE_A(PG8_SA(0, 1), a2, 1, last);
            PG8_WAIT_L(8); PG8_BAR; PG8_WAIT_L(0); PG8_MMA(0, 0, At, B0); PG8_BAR; PG8_SCHED;
            PG8_LDB(B1, 1, 1); PG8_STAGE(PG8_SB(1, 0), b3, voffB);
            PG8_BAR; PG8_WAIT_L(0); PG8_MMA(0, 1, At, B1); PG8_BAR;
            PG8_LDA(At, 1, 1); PG8_STAGE_A(PG8_SA(1, 0), a3, 0, last);
            PG8_BAR; PG8_WAIT_L(0); PG8_MMA(1, 0, At, B0); PG8_BAR; PG8_SCHED;
            PG8_STAGE(PG8_SB(1, 1), b3 + hstep, voffB);
            PG8_WAIT_V(6); PG8_BAR; PG8_MMA(1, 1, At, B1); PG8_BAR;
            }
        }
        if constexpr (FP8) asm volatile("s_nop 15\n\ts_nop 15" ::: "memory");
        if constexpr (ALIGN_EPI) { if (wr == 0) PG8_BAR; }
        if constexpr (!Epi::AFTER_DRAIN) { E(acc, cur, wr, wc, fr, fq); S.done(cur); }
        if (!has_next) break;
#pragma unroll
        for (int a = 0; a < 2; ++a)
#pragma unroll
            for (int b = 0; b < 2; ++b)
#pragma unroll
                for (int m = 0; m < 4; ++m)
#pragma unroll
                    for (int n = 0; n < 2; ++n) acc[a][b][m][n] = (f32x4){0.f, 0.f, 0.f, 0.f};
        cur = nxt; cA = nA; cB = nB; ++ui;
        if constexpr (GATHER) { gc[0][0] = gn[0][0]; gc[0][1] = gn[0][1]; gc[1][0] = gn[1][0]; gc[1][1] = gn[1][1]; }
        if constexpr (ALIGN_EPI) { if (wr == 1) PG8_BAR; }
    }
    PG8_WAIT_V(0);
    if constexpr (!ALIGN_EPI) { if (wr == 0) PG8_BAR; }
    PG8_BAR;
    if constexpr (Epi::AFTER_DRAIN) { E.fused(acc, cur, wr, wc, fr, fq, lds, wid, lane); S.done(cur); }
#undef PG8_TOK
#undef PG8_GOFF
#undef PG8_STAGE_A
#undef PG8_SA
#undef PG8_SB
#undef PG8_STAGE
#undef PG8_LDA
#undef PG8_LDB
#undef PG8_MMA
#undef PG8_WAIT_V
#undef PG8_WAIT_L
#undef PG8_BAR
#undef PG8_SCHED
}
__device__ __forceinline__ float bf_lo(unsigned w) { return __uint_as_float(w << 16); }
__device__ __forceinline__ float bf_hi(unsigned w) { return __uint_as_float(w & 0xffff0000u); }
__device__ __forceinline__ float sigmoidf_(float x) { return __builtin_amdgcn_rcpf(1.0f + __expf(-x)); }
struct EpiGlu {
    static constexpr bool PERM = true, AFTER_DRAIN = false;
    const bf16_t* G; bf16_t* O; int ldc; const float* bias;
    __device__ __forceinline__ void operator()(const f32x4 (&acc)[2][2][4][2], const Unit& u, int wr, int wc, int fr, int fq) const {
        const int row0 = u.pm * BM + wr * 64 + fr, col0 = u.pn * BM + wc * 32 + 8 * fq;
        f32x4 bv[2][2];
#pragma unroll
        for (int bj = 0; bj < 2; ++bj)
#pragma unroll
            for (int n = 0; n < 2; ++n) bv[bj][n] = *(const f32x4*)(bias + col0 + bj * HALF + 4 * n);
#pragma unroll
        for (int ai = 0; ai < 2; ++ai)
#pragma unroll
            for (int m = 0; m < 4; ++m) { const size_t ro = (size_t)(row0 + ai * HALF + m * 16) * ldc + col0;
#pragma unroll
                for (int bj = 0; bj < 2; ++bj) { const f32x4 v0 = acc[ai][bj][m][0] + bv[bj][0], v1 = acc[ai][bj][m][1] + bv[bj][1];
                    const u32x4 g = *(const u32x4*)(G + ro + bj * HALF);
                    const float o0 = bf_lo(g.x) * sigmoidf_(v0[0]), o1 = bf_hi(g.x) * sigmoidf_(v0[1]), o2 = bf_lo(g.y) * sigmoidf_(v0[2]), o3 = bf_hi(g.y) * sigmoidf_(v0[3]);
                    const float o4 = bf_lo(g.z) * sigmoidf_(v1[0]), o5 = bf_hi(g.z) * sigmoidf_(v1[1]), o6 = bf_lo(g.w) * sigmoidf_(v1[2]), o7 = bf_hi(g.w) * sigmoidf_(v1[3]);
                    u32x4 w; w.x = cvt_pk_bf16(o0, o1); w.y = cvt_pk_bf16(o2, o3); w.z = cvt_pk_bf16(o4, o5); w.w = cvt_pk_bf16(o6, o7);
                    *(u32x4*)(O + ro + bj * HALF) = w; } }
    }
};
struct EpiResF32 {
    static constexpr bool PERM = false, AFTER_DRAIN = false;
    const float* base; float* out; int ldc;
    __device__ __forceinline__ void operator()(const f32x4 (&acc)[2][2][4][2], const Unit& u, int wr, int wc, int fr, int fq) const {
        const int col0 = u.pn * BM + wc * 32 + 4 * fq;
#pragma unroll
        for (int ai = 0; ai < 2; ++ai)
#pragma unroll
            for (int m = 0; m < 4; ++m) { const size_t off = (size_t)(u.pm * BM + ai * HALF + wr * 64 + m * 16 + fr) * ldc + col0;
#pragma unroll
                for (int bj = 0; bj < 2; ++bj)
#pragma unroll
                    for (int n = 0; n < 2; ++n) { const f32x4 bs = *(const f32x4*)(base + off + bj * HALF + n * 16); *(f32x4*)(out + off + bj * HALF + n * 16) = bs + acc[ai][bj][m][n]; } }
    }
};
struct EpiResBf16 {
    static constexpr bool PERM = true, AFTER_DRAIN = false;
    const float* base; bf16_t* out; int ldc;
    __device__ __forceinline__ void operator()(const f32x4 (&acc)[2][2][4][2], const Unit& u, int wr, int wc, int fr, int fq) const {
        const int row0 = u.pm * BM + wr * 64 + fr, col0 = u.pn * BM + wc * 32 + 8 * fq;
#pragma unroll
        for (int ai = 0; ai < 2; ++ai)
#pragma unroll
            for (int m = 0; m < 4; ++m) { const size_t ro = (size_t)(row0 + ai * HALF + m * 16) * ldc + col0;
#pragma unroll
                for (int bj = 0; bj < 2; ++bj) { const f32x4 b0 = __builtin_nontemporal_load((const f32x4*)(base + ro + bj * HALF)), b1 = __builtin_nontemporal_load((const f32x4*)(base + ro + bj * HALF + 4));
                    const f32x4 v0 = acc[ai][bj][m][0] + b0, v1 = acc[ai][bj][m][1] + b1;
                    u32x4 w; w.x = cvt_pk_bf16(v0[0], v0[1]); w.y = cvt_pk_bf16(v0[2], v0[3]); w.z = cvt_pk_bf16(v1[0], v1[1]); w.w = cvt_pk_bf16(v1[2], v1[3]);
                    *(u32x4*)(out + ro + bj * HALF) = w; } }
    }
};
struct EpiSwiglu {
    static constexpr bool PERM = true, AFTER_DRAIN = false;
    bf16_t* O; int ldo; const float* bg; const float* bu;
    __device__ __forceinline__ void operator()(const f32x4 (&acc)[2][2][4][2], const Unit& u, int wr, int wc, int fr, int fq) const {
        const int e = u.pn >> 4, j = u.pn & 15, col0 = j * HALF + wc * 32 + 8 * fq, row0 = u.pm * BM + wr * 64 + fr;
        f32x4 g_b[2], u_b[2];
#pragma unroll
        for (int n = 0; n < 2; ++n) { g_b[n] = *(const f32x4*)(bg + (size_t)e * 2048 + col0 + 4 * n); u_b[n] = *(const f32x4*)(bu + (size_t)e * 2048 + col0 + 4 * n); }
#pragma unroll
        for (int ai = 0; ai < 2; ++ai)
#pragma unroll
            for (int m = 0; m < 4; ++m) { float h[8];
#pragma unroll
                for (int n = 0; n < 2; ++n)
#pragma unroll
                    for (int i = 0; i < 4; ++i) { const float g = fminf(acc[ai][0][m][n][i] + g_b[n][i], 7.0f); const float uu = fminf(fmaxf(acc[ai][1][m][n][i] + u_b[n][i], -7.0f), 7.0f);
                        h[n * 4 + i] = g * sigmoidf_(1.702f * g) * (uu + 1.0f); }
                u32x4 w; w.x = cvt_pk_bf16(h[0], h[1]); w.y = cvt_pk_bf16(h[2], h[3]); w.z = cvt_pk_bf16(h[4], h[5]); w.w = cvt_pk_bf16(h[6], h[7]);
                *(u32x4*)(O + (size_t)(row0 + ai * HALF + m * 16) * ldo + col0) = w; }
    }
};
__device__ __forceinline__ float sat8(float v) { return __builtin_amdgcn_fmed3f(v, -448.0f, 448.0f); }
__device__ __forceinline__ unsigned pk4_fp8(float a, float b, float c, float d) { int w = 0; w = __builtin_amdgcn_cvt_pk_fp8_f32(a, b, w, false); w = __builtin_amdgcn_cvt_pk_fp8_f32(c, d, w, true); return (unsigned)w; }
struct EpiSwiglu8 {
    static constexpr bool PERM = true, AFTER_DRAIN = false;
    unsigned char* O; int ldo; const float* bg; const float* bu;
    __device__ __forceinline__ void operator()(const f32x4 (&acc)[2][2][4][2], const Unit& u, int wr, int wc, int fr, int fq) const {
        const int e = u.pn >> 4, j = u.pn & 15, col0 = j * HALF + wc * 32 + 8 * fq, row0 = u.pm * BM + wr * 64 + fr;
        f32x4 g_b[2], u_b[2];
#pragma unroll
        for (int n = 0; n < 2; ++n) { g_b[n] = *(const f32x4*)(bg + (size_t)e * 2048 + col0 + 4 * n); u_b[n] = *(const f32x4*)(bu + (size_t)e * 2048 + col0 + 4 * n); }
#pragma unroll
        for (int ai = 0; ai < 2; ++ai)
#pragma unroll
            for (int m = 0; m < 4; ++m) { float h[8];
#pragma unroll
                for (int n = 0; n < 2; ++n)
#pragma unroll
                    for (int i = 0; i < 4; ++i) { const float g = fminf(acc[ai][0][m][n][i] + g_b[n][i], 7.0f); const float uu = fminf(fmaxf(acc[ai][1][m][n][i] + u_b[n][i], -7.0f), 7.0f);
                        h[n * 4 + i] = g * sigmoidf_(1.702f * g) * (uu + 1.0f); }
                typedef unsigned u32x2_t __attribute__((ext_vector_type(2)));
                u32x2_t w; w.x = pk4_fp8(h[0], h[1], h[2], h[3]); w.y = pk4_fp8(h[4], h[5], h[6], h[7]);
                *(u32x2_t*)(O + (size_t)(row0 + ai * HALF + m * 16) * ldo + col0) = w; }
    }
};
struct EpiFp8 {
    static constexpr bool PERM = true, AFTER_DRAIN = false;
    unsigned char* O; int ldc; const float* bias; int ncols;
    __device__ __forceinline__ void operator()(const f32x4 (&acc)[2][2][4][2], const Unit& u, int wr, int wc, int fr, int fq) const {
        const int row0 = u.pm * BM + wr * 64 + fr, bcol0 = u.pn * BM + wc * 32 + 8 * fq, col0 = bcol0 % ncols;
        f32x4 bv[2][2];
#pragma unroll
        for (int bj = 0; bj < 2; ++bj)
#pragma unroll
            for (int n = 0; n < 2; ++n) bv[bj][n] = *(const f32x4*)(bias + bcol0 + bj * HALF + 4 * n);
        typedef unsigned u32x2_t __attribute__((ext_vector_type(2)));
#pragma unroll
        for (int ai = 0; ai < 2; ++ai)
#pragma unroll
            for (int m = 0; m < 4; ++m) { unsigned char* rowp = O + (size_t)(row0 + ai * HALF + m * 16) * ldc + col0;
#pragma unroll
                for (int bj = 0; bj < 2; ++bj) { const f32x4 v0 = acc[ai][bj][m][0] + bv[bj][0], v1 = acc[ai][bj][m][1] + bv[bj][1];
                    u32x2_t w; w.x = pk4_fp8(sat8(v0[0]), sat8(v0[1]), sat8(v0[2]), sat8(v0[3])); w.y = pk4_fp8(sat8(v1[0]), sat8(v1[1]), sat8(v1[2]), sat8(v1[3]));
                    *(u32x2_t*)(rowp + bj * HALF) = w; } }
    }
};
struct MoeOrder {
    const PG8_LAS int* tb; int NT, G, c;
    __device__ __forceinline__ bool next(int i, Unit& u) const {
        const int x = c & 7, k = c >> 3, G8 = G >> 3, NL = NT >> 3;
        const long L = (long)i * G8 + k; const int total = tb[32] * NL; if (L >= (long)total) return false;
        int e = 0;
#pragma unroll 8
        for (int q = 1; q <= 32; ++q) e += (L >= (long)tb[q] * NL) ? 1 : 0;
        e = e > 31 ? 31 : e;
        const int t0 = tb[e], ne = tb[e + 1] - t0, r = (int)(L - (long)t0 * NL), nn = ne > 0 ? ne : 1;
        u.pn = __builtin_amdgcn_readfirstlane(e * NT + x * NL + r / nn); u.pm = __builtin_amdgcn_readfirstlane(t0 + r % nn); return true;
    }
    __device__ __forceinline__ void a_ready(const Unit&) const {}
    __device__ __forceinline__ void done(const Unit&) const {}
};
}
namespace att {
using bf16 = __hip_bfloat16;
constexpr int   D = 128, NW = 8, QBLK = 32, KVBLK = 64;
constexpr float SCALE = 0.088388347648318440f;
constexpr float THR = 0.f;
constexpr int LDQ = 1024, LDK = 1024, LDO = 1024;
constexpr size_t SHM_V = KVBLK * D * 2, SHM_K = KVBLK * D * 2, SHM_ATTN = 2 * SHM_V + 2 * SHM_K + NW * 64 * 4 + 1040;
using bf16x8 = __attribute__((ext_vector_type(8))) short;
using s16x4  = __attribute__((ext_vector_type(4))) short;
using f32x16 = __attribute__((ext_vector_type(16))) float;
using f32x8  = __attribute__((ext_vector_type(8))) float;
using u32x4  = __attribute__((ext_vector_type(4))) unsigned;
#define KSWZ(row, colB) ((row) * 256 + ((colB) ^ (((row) & 7) << 4)))
#define SBAR() __builtin_amdgcn_sched_barrier(0)
__device__ __forceinline__ int crow(int r, int hi) { return (r & 3) + 8 * (r >> 2) + 4 * hi; }
__device__ __forceinline__ unsigned cvtpk(float lo, float hi) {
  unsigned r; asm volatile("v_cvt_pk_bf16_f32 %0, %1, %2" : "=v"(r) : "v"(lo), "v"(hi)); return r;
}
template <typename TIn> struct Stage;
template <> struct Stage<bf16>  { using T = bf16x8;
  __device__ static __forceinline__ T ld8(const bf16* p) { return *reinterpret_cast<const bf16x8*>(p); }
  __device__ static __forceinline__ bf16x8 tobf(T x) { return x; } };
template <> struct Stage<float> { using T = f32x8;
  __device__ static __forceinline__ T ld8(const float* p) { return *reinterpret_cast<const f32x8*>(p); }
  __device__ static __forceinline__ bf16x8 tobf(T x) {
    u32x4 w = {cvtpk(x[0], x[1]), cvtpk(x[2], x[3]), cvtpk(x[4], x[5]), cvtpk(x[6], x[7])}; return *reinterpret_cast<bf16x8*>(&w); } };

__device__ __forceinline__ void partialSM(f32x16& p0, f32x16& p1, float& m_reg, float& mn, float& alpha) {
  constexpr float C = SCALE * 1.4426950408889634f;
  float pmax = p0[0]; for (int r = 1; r < 16; ++r) pmax = fmaxf(pmax, p0[r]); for (int r = 0; r < 16; ++r) pmax = fmaxf(pmax, p1[r]);
  { auto rr = __builtin_amdgcn_permlane32_swap(__float_as_uint(pmax), __float_as_uint(pmax), false, false);
    pmax = fmaxf(__uint_as_float(rr[0]), __uint_as_float(rr[1])); }
  if (__builtin_expect(__all(pmax - m_reg <= THR / SCALE), 1)) { mn = m_reg; alpha = 1.f; }
  else { mn = fmaxf(m_reg, pmax); alpha = __builtin_amdgcn_exp2f((m_reg - mn) * C); m_reg = mn; }
  float mnC = -mn * C;
  for (int r = 0; r < 16; ++r) p0[r] = fmaf(p0[r], C, mnC); for (int r = 0; r < 16; ++r) p1[r] = fmaf(p1[r], C, mnC);
  for (int r = 0; r < 16; ++r) p0[r] = __builtin_amdgcn_exp2f(p0[r]);
}
__device__ __forceinline__ void finishSM(f32x16& p0, f32x16& p1, float alpha, float& l_reg, bf16x8& pa0, bf16x8& pa1, bf16x8& pa2, bf16x8& pa3) {
  for (int r = 0; r < 16; ++r) p1[r] = __builtin_amdgcn_exp2f(p1[r]);
  float ps = 0; for (int r = 0; r < 16; ++r) ps += p0[r]; for (int r = 0; r < 16; ++r) ps += p1[r];
  { auto rr = __builtin_amdgcn_permlane32_swap(__float_as_uint(ps), __float_as_uint(ps), false, false);
    ps = __uint_as_float(rr[0]) + __uint_as_float(rr[1]); }
  l_reg = l_reg * alpha + ps;
#define PK4(P, BASE, OUT) do { unsigned a0 = cvtpk(P[BASE + 0], P[BASE + 1]), a1 = cvtpk(P[BASE + 2], P[BASE + 3]);   \
    unsigned b0 = cvtpk(P[BASE + 4], P[BASE + 5]), b1 = cvtpk(P[BASE + 6], P[BASE + 7]);                              \
    auto r0 = __builtin_amdgcn_permlane32_swap(a0, b0, false, false); auto r1 = __builtin_amdgcn_permlane32_swap(a1, b1, false, false); \
    u32x4 w = {r0[0], r1[0], r0[1], r1[1]}; OUT = *reinterpret_cast<bf16x8*>(&w); } while (0)
  PK4(p0, 0, pa0); PK4(p0, 8, pa1); PK4(p1, 0, pa2); PK4(p1, 8, pa3);
#undef PK4
}
__device__ __forceinline__ void qkt(f32x16& p0, f32x16& p1, const bf16* Ks, const bf16x8* qr, int r32, int hi) {
  p0 = f32x16{}; p1 = f32x16{};
  for (int d0 = 0; d0 < 8; ++d0) { int cb = (d0 * 16 + hi * 8) * 2;
    bf16x8 b0 = *reinterpret_cast<const bf16x8*>((const char*)Ks + KSWZ(r32, cb));
    bf16x8 b1 = *reinterpret_cast<const bf16x8*>((const char*)Ks + KSWZ(32 + r32, cb));
    p0 = __builtin_amdgcn_mfma_f32_32x32x16_bf16(b0, qr[d0], p0, 0, 0, 0);
    p1 = __builtin_amdgcn_mfma_f32_32x32x16_bf16(b1, qr[d0], p1, 0, 0, 0); }
}
__device__ __forceinline__ int v_st(int k, int c) { const int kk = (k & ~0xC) | ((k & 4) << 1) | ((k & 8) >> 1); return ((kk >> 3) * 4 + (c >> 5)) * 512 + ((kk & 7) * 32 + (c & 31)) * 2; }
__device__ __forceinline__ int v_rd_base(int lane) { return ((lane & 3) << 3) | (((lane >> 2) & 3) << 6) | (((lane >> 4) & 1) << 5) | (((lane >> 5) & 1) << 8); }
constexpr int v_rd_off(int d0, int ks, int half) { return d0 * 512 + ks * 4096 + half * 2048; }
template <int OFF> __device__ __forceinline__ s16x4 tr_read(int vb) {
  s16x4 r; asm volatile("ds_read_b64_tr_b16 %0, %1 offset:%2" : "=&v"(r) : "v"(vb), "i"(OFF) : "memory"); return r;
}
template <int D0> __device__ __forceinline__ void pv_one(f32x16& od, int vb, bf16x8 pa0, bf16x8 pa1, bf16x8 pa2, bf16x8 pa3) {
  const s16x4 l0 = tr_read<v_rd_off(D0, 0, 0)>(vb), h0 = tr_read<v_rd_off(D0, 0, 1)>(vb), l1 = tr_read<v_rd_off(D0, 1, 0)>(vb), h1 = tr_read<v_rd_off(D0, 1, 1)>(vb);
  const s16x4 l2 = tr_read<v_rd_off(D0, 2, 0)>(vb), h2 = tr_read<v_rd_off(D0, 2, 1)>(vb), l3 = tr_read<v_rd_off(D0, 3, 0)>(vb), h3 = tr_read<v_rd_off(D0, 3, 1)>(vb);
  asm volatile("s_waitcnt lgkmcnt(0)" ::: "memory"); SBAR();
#define PK(L, H) (bf16x8){L[0], L[1], L[2], L[3], H[0], H[1], H[2], H[3]}
  od = __builtin_amdgcn_mfma_f32_32x32x16_bf16(pa0, PK(l0, h0), od, 0, 0, 0);
  od = __builtin_amdgcn_mfma_f32_32x32x16_bf16(pa1, PK(l1, h1), od, 0, 0, 0);
  od = __builtin_amdgcn_mfma_f32_32x32x16_bf16(pa2, PK(l2, h2), od, 0, 0, 0);
  od = __builtin_amdgcn_mfma_f32_32x32x16_bf16(pa3, PK(l3, h3), od, 0, 0, 0);
#undef PK
}
__device__ __forceinline__ void pv_d0(f32x16* o, int vb, bf16x8 pa0, bf16x8 pa1, bf16x8 pa2, bf16x8 pa3) {
  pv_one<0>(o[0], vb, pa0, pa1, pa2, pa3); pv_one<1>(o[1], vb, pa0, pa1, pa2, pa3); pv_one<2>(o[2], vb, pa0, pa1, pa2, pa3); pv_one<3>(o[3], vb, pa0, pa1, pa2, pa3);
}

__device__ __forceinline__ void bias_mask(f32x16& p0, f32x16& p1, int t, bool valid, int qi, int hi, const float* bt) {
  if (!valid) {
#pragma unroll
    for (int r = 0; r < 16; ++r) { p0[r] = -INFINITY; p1[r] = -INFINITY; }
  } else if (t <= 5) {
    const float c = bt[256];
#pragma unroll
    for (int r = 0; r < 16; ++r) { p0[r] += c; p1[r] += c; }
  } else {
    const int base = 512 + qi - 64 * t;
#pragma unroll
    for (int r = 0; r < 16; ++r) { const int kt = crow(r, hi);
      int r0 = base - kt; r0 = r0 < -128 ? -128 : (r0 > 128 ? 128 : r0);
      int r1 = base - kt - 32; r1 = r1 < -128 ? -128 : (r1 > 128 ? 128 : r1);
      p0[r] += bt[r0 + 128]; p1[r] += bt[r1 + 128]; }
  }
}
__device__ __forceinline__ void attn_unit(int b, int h, int qb, const bf16* __restrict__ Q, const bf16* __restrict__ K, const bf16* __restrict__ V, bf16* __restrict__ O,
                                          const float* __restrict__ rel_bias, char* lds) {
  using St = Stage<bf16>;
  const int tid = threadIdx.x, wid = __builtin_amdgcn_readfirstlane(tid >> 6), lane = tid & 63, r32 = lane & 31, hi = lane >> 5;
  bf16* V_lds = (bf16*)lds; bf16* K_lds = (bf16*)(lds + 2 * SHM_V);
  float* ws = (float*)(lds + 2 * SHM_V + 2 * SHM_K) + wid * 64; float* li_l = ws; float* al_l = ws + 32;
  float* bt = (float*)(lds + 2 * SHM_V + 2 * SHM_K + NW * 64 * 4);
  for (int i = tid; i < 257; i += 64 * NW) bt[i] = rel_bias[h * 257 + i] * (1.0f / SCALE);
  const long rowb = (long)b * 2048;
  const bf16* Qb = Q + (rowb + qb * 256) * LDQ + h * D;
  const bf16* Kh = K + rowb * LDK + h * D; const bf16* Vh = V + rowb * LDK + h * D;
  bf16* Ob = O + (rowb + qb * 256) * LDO + h * D;
  const int cbase = qb * 4 - 8;
  const int ci = wid >> 1, qi = (wid & 1) * 32 + r32;
  float m_reg = -1e30f, l_reg = 0; f32x16 o[4] = {}; bf16x8 qr[8];
  const bf16* Qw = Qb + (long)(wid * QBLK + r32) * LDQ + hi * 8;
#pragma unroll
  for (int d0 = 0; d0 < 8; ++d0) qr[d0] = St::tobf(St::ld8(Qw + d0 * 16));
  const int sr = tid >> 4, sc = (tid & 15) * 8, vst0 = v_st(sr, sc), vst1 = v_st(32 + sr, sc);
  const int vb0 = (int)(uintptr_t)V_lds + v_rd_base(lane);
  struct { typename St::T vs0, vs1, ks0, ks1; } sr_[2];
#define KSTART(j) ((((cbase + (j)) < 0) ? 0 : (cbase + (j))) * 64)
#define TVALID(j) (((j) - ci) >= 0 && ((j) - ci) <= 8 && (cbase + (j)) >= 0)
#define SLOAD(i, k0) do { sr_[i].vs0 = St::ld8(&Vh[(long)((k0) + sr) * LDK + sc]); sr_[i].vs1 = St::ld8(&Vh[(long)((k0) + 32 + sr) * LDK + sc]); \
    sr_[i].ks0 = St::ld8(&Kh[(long)((k0) + sr) * LDK + sc]); sr_[i].ks1 = St::ld8(&Kh[(long)((k0) + 32 + sr) * LDK + sc]); } while (0)
#define SWRITE(bb, i) do { *(bf16x8*)((char*)V_lds + (bb) * SHM_V + vst0) = St::tobf(sr_[i].vs0);          \
    *(bf16x8*)((char*)V_lds + (bb) * SHM_V + vst1) = St::tobf(sr_[i].vs1); int kc = sc * 2;               \
    *(bf16x8*)((char*)K_lds + (bb) * SHM_K + KSWZ(sr, kc)) = St::tobf(sr_[i].ks0);                       \
    *(bf16x8*)((char*)K_lds + (bb) * SHM_K + KSWZ(32 + sr, kc)) = St::tobf(sr_[i].ks1); } while (0)
#define SWAIT() asm volatile("s_waitcnt vmcnt(4)" ::: "memory")
#define RESC(a) do { if (__any((a) < 1.f)) { if (hi == 0) al_l[r32] = (a); asm volatile("s_waitcnt lgkmcnt(0)" ::: "memory"); \
    for (int d = 0; d < 4; ++d) for (int r = 0; r < 16; ++r) o[d][r] *= al_l[crow(r, hi)]; } } while (0)
  f32x16 pA0, pA1, pB0, pB1; float mnA, mnB, alA, alB; bf16x8 pa0, pa1, pa2, pa3; constexpr int NT = 12;
  constexpr int SE = 0, SO = 1;
  SLOAD(SE, KSTART(0)); asm volatile("s_waitcnt vmcnt(0)" ::: "memory"); SWRITE(0, SE); __syncthreads();
  qkt(pA0, pA1, K_lds, qr, r32, hi); bias_mask(pA0, pA1, 0 - ci, TVALID(0), qi, hi, bt); partialSM(pA0, pA1, m_reg, mnA, alA);
  SLOAD(SO, KSTART(1)); SLOAD(SE, KSTART(2));
  SWAIT(); SWRITE(1, SO); __syncthreads();
  for (int j = 1; j + 1 < NT; j += 2) {
    SBAR(); qkt(pB0, pB1, (bf16*)((char*)K_lds + SHM_K), qr, r32, hi);
    finishSM(pA0, pA1, alA, l_reg, pa0, pa1, pa2, pa3); SBAR();
    SLOAD(SO, KSTART(j + 2)); SBAR();
    pv_d0(o, vb0, pa0, pa1, pa2, pa3); bias_mask(pB0, pB1, j - ci, TVALID(j), qi, hi, bt); partialSM(pB0, pB1, m_reg, mnB, alB);
    __syncthreads(); SWAIT(); SWRITE(0, SE);
    RESC(alB); __syncthreads();
    SBAR(); qkt(pA0, pA1, K_lds, qr, r32, hi);
    finishSM(pB0, pB1, alB, l_reg, pa0, pa1, pa2, pa3); SBAR();
    if (j + 3 < NT) SLOAD(SE, KSTART(j + 3)); SBAR();
    pv_d0(o, vb0 + (int)SHM_V, pa0, pa1, pa2, pa3); bias_mask(pA0, pA1, j + 1 - ci, TVALID(j + 1), qi, hi, bt); partialSM(pA0, pA1, m_reg, mnA, alA);
    __syncthreads(); SWAIT(); SWRITE(1, SO);
    RESC(alA); __syncthreads();
  }
  SBAR(); qkt(pB0, pB1, (bf16*)((char*)K_lds + SHM_K), qr, r32, hi);
  finishSM(pA0, pA1, alA, l_reg, pa0, pa1, pa2, pa3); SBAR();
  pv_d0(o, vb0, pa0, pa1, pa2, pa3); bias_mask(pB0, pB1, NT - 1 - ci, TVALID(NT - 1), qi, hi, bt); partialSM(pB0, pB1, m_reg, mnB, alB);
  __syncthreads(); RESC(alB);
  finishSM(pB0, pB1, alB, l_reg, pa0, pa1, pa2, pa3); SBAR();
  pv_d0(o, vb0 + (int)SHM_V, pa0, pa1, pa2, pa3);
  if (hi == 0) li_l[r32] = l_reg; asm volatile("s_waitcnt lgkmcnt(0)" ::: "memory");
  float rli[16];
#pragma unroll
  for (int r = 0; r < 16; ++r) rli[r] = __builtin_amdgcn_rcpf(li_l[crow(r, hi)]);
  bf16* Ow = Ob + (long)(wid * QBLK) * LDO;
#pragma unroll
  for (int r = 0; r < 16; ++r) { const int orow = crow(r, hi);
#pragma unroll
    for (int d0 = 0; d0 < 4; ++d0) Ow[(long)orow * LDO + d0 * 32 + r32] = __float2bfloat16(o[d0][r] * rli[r]); }
  __syncthreads();
#undef KSTART
#undef TVALID
#undef SLOAD
#undef SWRITE
#undef SWAIT
#undef RESC
}
}
#define GAS __attribute__((address_space(1)))
#define LAS __attribute__((address_space(3)))
#define XB_TMO      128
#define XB_XCNT(j)  (256  + 64 * (j))
#define XB_XSUB(j)  (1280 + 64 * (j))
#define XB_XGEN(j)  (2304 + 64 * (j))
#define XB_TOP      3328
#define XB_TOPGEN   3392
#define XCD_BAR_WORDS 3456
#define XB_SPIN_CAP (1u << 18)

__device__ __forceinline__ unsigned xb_ld(unsigned* p)              { return __hip_atomic_load(p, __ATOMIC_RELAXED, __HIP_MEMORY_SCOPE_AGENT); }
__device__ __forceinline__ unsigned xb_add(unsigned* p, unsigned v) { return __hip_atomic_fetch_add(p, v, __ATOMIC_RELAXED, __HIP_MEMORY_SCOPE_AGENT); }
__device__ __forceinline__ unsigned xb_xcc_id() { return (unsigned)__builtin_amdgcn_s_getreg((3 << 11) | 20) & 0xFu; }
#define XB_SPIN(cond, bar) do { unsigned _sp = 0; while (cond) { __builtin_amdgcn_s_sleep(1); \
    if ((++_sp & 255u) == 0u) { if (xb_ld(&(bar)[XB_TMO])) break; if (_sp > XB_SPIN_CAP) { atomicAdd(&(bar)[XB_TMO], 1u); break; } } } } while (0)

struct XcdBarrier {
    unsigned* bar; unsigned x;
    volatile LAS unsigned* st;
};

__device__ __forceinline__ XcdBarrier xcd_barrier_post(unsigned* bar, volatile LAS unsigned* st) {
    XcdBarrier b; b.bar = bar; b.x = xb_xcc_id(); b.st = st;
    if (threadIdx.x == 0) (void)xb_add(&bar[XB_XCNT(b.x)], 1u);
    return b;
}
__device__ __forceinline__ void xcd_barrier_complete(unsigned* bar, unsigned x, unsigned& nloc, unsigned& nx) {
    const unsigned G = gridDim.x * gridDim.y * gridDim.z;
    unsigned sum, cnt, mine, sp = 0u;
    for (;;) {
        sum = 0u; cnt = 0u; mine = 0u;
#pragma unroll
        for (unsigned j = 0; j < 16; ++j) { const unsigned c = xb_ld(&bar[XB_XCNT(j)]); sum += c; cnt += (c > 0u) ? 1u : 0u; mine = (j == x) ? c : mine; }
        if (sum == G) break;
        __builtin_amdgcn_s_sleep(1);
        if ((++sp & 255u) == 0u) { if (xb_ld(&bar[XB_TMO])) break; if (sp > XB_SPIN_CAP) { atomicAdd(&bar[XB_TMO], 1u); break; } }
    }
    nloc = mine > 0u ? mine : 1u; nx = cnt > 0u ? cnt : 1u;
}

__device__ __forceinline__ void xcd_barrier(const XcdBarrier& b) {
    asm volatile("s_waitcnt vmcnt(0)" ::: "memory");
    __syncthreads();
    if (threadIdx.x == 0) {
        unsigned* bar = b.bar;
        __builtin_amdgcn_s_waitcnt(0);
        unsigned nloc = b.st[0], nx = b.st[1];
        if (nloc == 0u) { xcd_barrier_complete(bar, b.x, nloc, nx); b.st[0] = nloc; b.st[1] = nx; }
        const unsigned old = xb_add(&bar[XB_XSUB(b.x)], 1u);
        const unsigned gen = old / nloc;
        if (old + 1u == (gen + 1u) * nloc) {
            __builtin_amdgcn_fence(__ATOMIC_RELEASE, "agent");
            asm volatile("s_waitcnt vmcnt(0)" ::: "memory");
            const unsigned og = xb_add(&bar[XB_TOP], 1u);
            const unsigned tg = og / nx;
            if (og + 1u == (tg + 1u) * nx) xb_add(&bar[XB_TOPGEN], 1u);
            else XB_SPIN(xb_ld(&bar[XB_TOPGEN]) == tg, bar);
            __builtin_amdgcn_fence(__ATOMIC_ACQUIRE, "agent");
            xb_add(&bar[XB_XGEN(b.x)], 1u);
            asm volatile("s_waitcnt vmcnt(0)" ::: "memory");
        } else {
            XB_SPIN(xb_ld(&bar[XB_XGEN(b.x)]) == gen, bar);
            __builtin_amdgcn_fence(__ATOMIC_ACQUIRE, "agent");
            asm volatile("s_waitcnt vmcnt(0)" ::: "memory");
        }
    }
    __syncthreads();
}
constexpr int NWAVES = 8;
constexpr int NB = 8, SEQ = 2048, DM = 2048, T = NB * SEQ;
constexpr int AW = 1024, NH = 8, HD = 128, SW = 1024, NG = 64, GC = 16, NP = 64, INW = 4096;
constexpr int NE = 32, DFF = 2048, NREL = 257;
constexpr float EPS = 1e-5f;
#ifndef MK_N_LAUNCHES
#define MK_N_LAUNCHES 1
#endif
constexpr int NPH = 11;
constexpr int N_LAUNCHES = MK_N_LAUNCHES;

constexpr size_t MiB = 1u << 20;
constexpr size_t WS_CTL = 0, CTL_ZERO_BYTES = 1 * MiB;
constexpr size_t WS_ABAR = 1 * MiB;
constexpr size_t WS_TB = 1 * MiB + 64 * 1024;
constexpr size_t WS_TC = 1 * MiB + 64 * 1024 + 256 * 1024;
constexpr size_t WS_LIST = 2 * MiB;
constexpr size_t WS_TOKE = 4 * MiB, WS_TOKP = 4 * MiB + 256 * 1024, WS_TOKG = 4 * MiB + 512 * 1024;
constexpr size_t WS_WIN = 8 * MiB, WS_WGLU = 24 * MiB, WS_WOUT = 26 * MiB;
constexpr size_t WS_XN = 34 * MiB;
constexpr size_t WS_Q = 98 * MiB, WS_K = 130 * MiB, WS_V = 162 * MiB, WS_U = 194 * MiB;
constexpr size_t WS_AO = 226 * MiB, WS_G = 258 * MiB, WS_S = 290 * MiB;
constexpr size_t WS_MIX = 322 * MiB;
constexpr size_t WS_H1 = 386 * MiB;
constexpr size_t WS_WGU = 514 * MiB;
constexpr size_t WS_XN8 = 770 * MiB;
constexpr size_t WS_WD = 1026 * MiB;
constexpr size_t WS_Y = 1282 * MiB;
constexpr size_t WS_XG = 1570 * MiB;
constexpr size_t WS_HID = 1714 * MiB;
constexpr size_t WS_END = 1858 * MiB;
constexpr int CW_BAR = 4096, CW_CNT = 8192, CW_QUEUE = 12288, CW_P1DONE = 12288 + 128;

constexpr int RING_OFF = 0, RING_BYTES = 139264;
constexpr int MISC_OFF = RING_BYTES;
constexpr int LDS_BYTES = 147456;

typedef unsigned short bf16_t;
typedef unsigned v4u __attribute__((ext_vector_type(4)));
typedef unsigned v2u __attribute__((ext_vector_type(2)));
typedef float f32x4 __attribute__((ext_vector_type(4)));
typedef float f32x2 __attribute__((ext_vector_type(2)));
typedef float f32x16 __attribute__((ext_vector_type(16)));
typedef short bf16x8 __attribute__((ext_vector_type(8)));
#define LDS_WAIT() asm volatile("s_waitcnt lgkmcnt(0)" ::: "memory")
#define VM_WAIT() asm volatile("s_waitcnt vmcnt(0)" ::: "memory")
__device__ __forceinline__ unsigned f2bf(float f) { unsigned u = __builtin_bit_cast(unsigned, f); return (u + 0x7fffu + ((u >> 16) & 1u)) >> 16; }
__device__ __forceinline__ unsigned pk2(float lo, float hi) { return f2bf(lo) | (f2bf(hi) << 16); }
__device__ __forceinline__ float bflo(unsigned w) { return __uint_as_float(w << 16); }
__device__ __forceinline__ float bfhi(unsigned w) { return __uint_as_float(w & 0xffff0000u); }
__device__ __forceinline__ float wave_sum(float v) {
#pragma unroll
    for (int o = 1; o < 64; o <<= 1) v += __shfl_xor(v, o);
    return v;
}
__device__ __forceinline__ float gelu_tanh(float y) {
    const float z = 0.7978845608028654f * (y + 0.044715f * y * y * y);
    const float e = __expf(2.0f * z);
    const float th = 1.0f - 2.0f * __builtin_amdgcn_rcpf(e + 1.0f);
    return 0.5f * y * (1.0f + th);
}

struct Frame {
    LAS unsigned char* lds;
    volatile LAS unsigned* MISC;
    unsigned* ctl;
    int tid, lane, wave, G;
};

struct TrItem { const float* src; bf16_t* dst; int N, K; };
__device__ __forceinline__ bool p0_item_decode(const float* const* in, unsigned char* ws, long it, TrItem& t) {
    if (it < 4096) { const int kb = (int)it / 128, nb = (int)it % 128; t.N = INW; t.K = DM; t.src = in[2] + (size_t)(64 * kb) * INW + 32 * nb; t.dst = (bf16_t*)(ws + WS_WIN) + (size_t)(32 * nb) * DM + 64 * kb; return true; }
    it -= 4096;
    if (it < 512) { const int kb = (int)it / 32, nb = (int)it % 32; t.N = SW; t.K = SW; t.src = in[12] + (size_t)(64 * kb) * SW + 32 * nb; t.dst = (bf16_t*)(ws + WS_WGLU) + (size_t)(32 * nb) * SW + 64 * kb; return true; }
    it -= 512;
    if (it < 2048) { const int kb = (int)it / 64, nb = (int)it % 64; t.N = DM; t.K = DM; t.src = in[16] + (size_t)(64 * kb) * DM + 32 * nb; t.dst = (bf16_t*)(ws + WS_WOUT) + (size_t)(32 * nb) * DM + 64 * kb; return true; }
    it -= 2048;
    if (it < (long)NE * 3 * 2048) {
        const int e = (int)(it / 6144), r = (int)(it % 6144), which = r / 2048, q = r % 2048, kb = q / 64, nb = q % 64, n0 = 32 * nb;
        t.N = 2048; t.K = 2048;
        const float* W = which == 0 ? in[20] : (which == 1 ? in[22] : in[24]);
        t.src = W + (size_t)e * 2048 * 2048 + (size_t)(64 * kb) * 2048 + n0;
        if (which == 2) t.dst = (bf16_t*)(ws + WS_WD) + ((size_t)e * 2048 + n0) * 2048 + 64 * kb;
        else t.dst = (bf16_t*)(ws + WS_WGU) + ((size_t)e * 4096 + (size_t)(n0 >> 7) * 256 + (which == 1 ? 128 : 0) + (n0 & 127)) * 2048 + 64 * kb;
        return true;
    }
    return false;
}
constexpr long P0_NITEMS = 4096 + 512 + 2048 + (long)NE * 3 * 2048;
__device__ __forceinline__ void p0_item_load(const TrItem& t, int lane, f32x4 (&v)[8]) {
    const float* p = t.src + (size_t)(lane >> 3) * t.N + 4 * (lane & 7);
#pragma unroll
    for (int i = 0; i < 8; ++i) v[i] = *(const f32x4*)(p + (size_t)(8 * i) * t.N);
}
__device__ __forceinline__ void p0_item_store(const TrItem& t, int lane, const f32x4 (&v)[8], LAS float* scr) {
    const int kk = lane >> 3, n4 = 4 * (lane & 7);
#pragma unroll
    for (int i = 0; i < 8; ++i) { LAS float* s = scr + (kk + 8 * i) * 33 + n4; s[0] = v[i][0]; s[1] = v[i][1]; s[2] = v[i][2]; s[3] = v[i][3]; }
    LDS_WAIT();
    const int c = lane & 7;
#pragma unroll
    for (int j = 0; j < 4; ++j) { const int n = (lane >> 3) + 8 * j; const LAS float* s = scr + (8 * c) * 33 + n;
        v4u o; o.x = pg8::cvt_pk_bf16(s[0 * 33], s[1 * 33]); o.y = pg8::cvt_pk_bf16(s[2 * 33], s[3 * 33]); o.z = pg8::cvt_pk_bf16(s[4 * 33], s[5 * 33]); o.w = pg8::cvt_pk_bf16(s[6 * 33], s[7 * 33]);
        *(v4u*)(t.dst + (size_t)n * t.K + 8 * c) = o; }
    LDS_WAIT();
}
__device__ __forceinline__ void rms_row_to_bf16(const float* xrow, const float* gain, bf16_t* orow, int lane) {
    f32x4 v[8]; float s = 0.f;
#pragma unroll
    for (int j = 0; j < 8; ++j) { v[j] = *(const f32x4*)(xrow + 4 * (lane + 64 * j)); s += (v[j].x * v[j].x + v[j].y * v[j].y) + (v[j].z * v[j].z + v[j].w * v[j].w); }
    const float r = 1.0f / sqrtf(wave_sum(s) * (1.0f / DM) + EPS);
#pragma unroll
    for (int j = 0; j < 8; ++j) { const f32x4 g = *(const f32x4*)(gain + 4 * (lane + 64 * j));
        v2u o; o.x = pk2(v[j].x * r * g.x, v[j].y * r * g.y); o.y = pk2(v[j].z * r * g.z, v[j].w * r * g.w);
        *(v2u*)(orow + 4 * (lane + 64 * j)) = o; }
}
__device__ __forceinline__ void s5_disc(const float* const* in, int g, int p, double& are, double& aim, double& fre, double& fim) {
    const double dt = exp((double)in[6][g]); const double lr = (double)in[4][g * 64 + p], li = (double)in[5][g * 64 + p];
    const double mag = exp(lr * dt); are = mag * cos(li * dt); aim = mag * sin(li * dt);
    const double den = lr * lr + li * li, nr = are - 1.0, ni = aim;
    fre = (nr * lr + ni * li) / den; fim = (ni * lr - nr * li) / den;
}
__device__ __forceinline__ void conv_items(const float* const* in, unsigned char* ws, long it0, long step, int n, LAS float* scr, int lane) {
    if (n <= 0) return;
    TrItem t0, t1, t2, t3; f32x4 v0[8], v1[8], v2[8], v3[8];
#define CV_LOAD(T_, V_, idx) do { if ((idx) < n) { p0_item_decode(in, ws, it0 + (long)(idx) * step, T_); p0_item_load(T_, lane, V_); } } while (0)
#define CV_STORE(T_, V_, idx) do { if ((idx) < n) p0_item_store(T_, lane, V_, scr); } while (0)
    CV_LOAD(t0, v0, 0); CV_LOAD(t1, v1, 1); CV_LOAD(t2, v2, 2);
    for (int i = 0; i < n; i += 4) {
        CV_LOAD(t3, v3, i + 3); CV_STORE(t0, v0, i);
        CV_LOAD(t0, v0, i + 4); CV_STORE(t1, v1, i + 1);
        CV_LOAD(t1, v1, i + 5); CV_STORE(t2, v2, i + 2);
        CV_LOAD(t2, v2, i + 6); CV_STORE(t3, v3, i + 3);
    }
#undef CV_LOAD
#undef CV_STORE
}
constexpr int P0_SMALL_ITEMS = 4096 + 512 + 2048;
struct TrItem8 { const float* src; unsigned char* dst; };
__device__ __forceinline__ void p8_item_decode(const float* const* in, unsigned char* ws, int it, TrItem8& t) {
    const int e = it / 3072, r = it % 3072, which = r >> 10, q = r & 1023, kb = q >> 6, nb = q & 63, n0 = 32 * nb, k0 = 128 * kb;
    const float* W = which == 0 ? in[20] : (which == 1 ? in[22] : in[24]);
    t.src = W + (size_t)e * 2048 * 2048 + (size_t)k0 * 2048 + n0;
    if (which == 2) t.dst = ws + WS_WD + ((size_t)e * 2048 + n0) * 2048 + k0;
    else t.dst = ws + WS_WGU + ((size_t)e * 4096 + (size_t)(n0 >> 7) * 256 + (which == 1 ? 128 : 0) + (n0 & 127)) * 2048 + k0;
}
__device__ __forceinline__ void p8_item_load(const TrItem8& t, int lane, f32x4 (&v)[16]) {
    const float* p = t.src + (size_t)(4 * (lane >> 3)) * 2048 + 4 * (lane & 7);
#pragma unroll
    for (int i = 0; i < 4; ++i)
#pragma unroll
        for (int kq = 0; kq < 4; ++kq) v[4 * i + kq] = __builtin_nontemporal_load((const f32x4*)(p + (size_t)(32 * i + kq) * 2048));
}
__device__ __forceinline__ void p8_item_store(const TrItem8& t, int lane, const f32x4 (&v)[16], LAS unsigned* scr) {
    const int kb4 = lane >> 3, n4 = 4 * (lane & 7);
#pragma unroll
    for (int i = 0; i < 4; ++i)
#pragma unroll
        for (int q = 0; q < 4; ++q)
            scr[(n4 + q) * 33 + kb4 + 8 * i] = pg8::pk4_fp8(v[4 * i][q] * 32.0f, v[4 * i + 1][q] * 32.0f, v[4 * i + 2][q] * 32.0f, v[4 * i + 3][q] * 32.0f);
    LDS_WAIT();
    const int c = lane & 7;
#pragma unroll
    for (int j = 0; j < 4; ++j) { const int n = (lane >> 3) + 8 * j; const LAS unsigned* s = scr + n * 33 + 4 * c;
        v4u o; o.x = s[0]; o.y = s[1]; o.z = s[2]; o.w = s[3];
        __builtin_nontemporal_store(o, (v4u*)(t.dst + (size_t)n * 2048 + 16 * c)); }
    LDS_WAIT();
}
constexpr int CONV_UNIT_ITEMS = 64, N_CONV_UNITS = NE * 3 * 1024 / CONV_UNIT_ITEMS;
constexpr int CONV8_WAVE_BYTES = 32 * 33 * 4;
__device__ __forceinline__ void conv_unit8(const float* const* in, unsigned char* ws, int cu, int wave, int lane, LAS unsigned* scr) {
    TrItem8 ta, tb_; f32x4 va[16], vb[16];
    const int it0 = cu * CONV_UNIT_ITEMS + wave;
    p8_item_decode(in, ws, it0, ta); p8_item_load(ta, lane, va);
#pragma unroll 1
    for (int i = 0; i < CONV_UNIT_ITEMS / NWAVES; i += 2) {
        p8_item_decode(in, ws, it0 + 8 * (i + 1), tb_); p8_item_load(tb_, lane, vb);
        p8_item_store(ta, lane, va, scr);
        if (i + 2 < CONV_UNIT_ITEMS / NWAVES) { p8_item_decode(in, ws, it0 + 8 * (i + 2), ta); p8_item_load(ta, lane, va); }
        p8_item_store(tb_, lane, vb, scr);
    }
}
__device__ __forceinline__ void p0_prologue(Frame& F, const float* const* in, unsigned char* ws) {
    LAS float* scr = (LAS float*)(F.lds + RING_OFF + F.wave * 16384);
    const int gw = (int)blockIdx.x * NWAVES + F.wave, NGW = F.G * NWAVES;
    { const int n = gw < P0_SMALL_ITEMS ? (P0_SMALL_ITEMS - gw + NGW - 1) / NGW : 0; conv_items(in, ws, gw, NGW, n, scr, F.lane); }
    for (int m = gw; m < T; m += NGW) rms_row_to_bf16(in[0] + (size_t)m * DM, in[1], (bf16_t*)(ws + WS_XN) + (size_t)m * DM, F.lane);
    for (int it = gw; it < 64 + 256 + 256; it += NGW) {
        if (it < 64) { const int g = it, p = F.lane; double are, aim, fre, fim; s5_disc(in, g, p, are, aim, fre, fim);
            float* ab = (float*)(ws + WS_ABAR) + (g * 64 + p) * 2; ab[0] = (float)are; ab[1] = (float)aim; }
        else if (it < 320) { const int g = (it - 64) >> 2, cb = (it - 64) & 3, col = 32 * cb + (F.lane & 31), hi = F.lane >> 5, p = col & 63; const bool im = col >= 64;
            double are, aim, fre, fim; s5_disc(in, g, p, are, aim, fre, fim);
            unsigned w[4];
#pragma unroll
            for (int j2 = 0; j2 < 4; ++j2) { float o[2];
#pragma unroll
                for (int q = 0; q < 2; ++q) { const int c = 8 * hi + 2 * j2 + q; const double br = (double)in[7][(g * 64 + p) * 16 + c], bi = (double)in[8][(g * 64 + p) * 16 + c];
                    o[q] = (float)(im ? (fre * bi + fim * br) : (fre * br - fim * bi)); }
                w[j2] = pk2(o[0], o[1]); }
            *(v4u*)((bf16_t*)(ws + WS_TB) + ((size_t)(g * 4 + cb) * 64 + F.lane) * 8) = (v4u){w[0], w[1], w[2], w[3]}; }
        else { const int g = (it - 320) >> 2, kk = (it - 320) & 3, c = F.lane & 15, kq = F.lane >> 4;
            unsigned w[4];
#pragma unroll
            for (int j2 = 0; j2 < 4; ++j2) { float o[2];
#pragma unroll
                for (int q = 0; q < 2; ++q) { const int k = 32 * kk + 8 * kq + 2 * j2 + q;
                    o[q] = k < 64 ? in[9][(g * 16 + c) * 64 + k] : -in[10][(g * 16 + c) * 64 + (k - 64)]; }
                w[j2] = pk2(o[0], o[1]); }
            *(v4u*)((bf16_t*)(ws + WS_TC) + ((size_t)(g * 4 + kk) * 64 + F.lane) * 8) = (v4u){w[0], w[1], w[2], w[3]}; }
    }
}

constexpr int S5_ROWF = 132, S5_WAVE_BYTES = 32 * S5_ROWF * 4;
static_assert(NWAVES * S5_WAVE_BYTES <= RING_BYTES, "S5 scratch");
__device__ __forceinline__ void s5_sequence(int s, const bf16_t* U, bf16_t* Gout, const float* ABAR, const bf16_t* TB, const bf16_t* TC, const float* dvec, LAS unsigned char* ldsw, int lane) {
    const int b = s >> 6, g = s & 63, r32 = lane & 31, hi = lane >> 5, c16 = lane & 15, fq = lane >> 4;
    const bf16_t* Ub = U + (size_t)b * SEQ * SW + g * GC;
    bf16_t* Gb = Gout + (size_t)b * SEQ * SW + g * GC;
    bf16x8 bfr[4], cfr[4];
#pragma unroll
    for (int i = 0; i < 4; ++i) { bfr[i] = *(const bf16x8*)(TB + ((size_t)(g * 4 + i) * 64 + lane) * 8); cfr[i] = *(const bf16x8*)(TC + ((size_t)(g * 4 + i) * 64 + lane) * 8); }
    const float are = ABAR[(g * 64 + lane) * 2], aim = ABAR[(g * 64 + lane) * 2 + 1], dv = dvec[g * GC + c16];
    float hr = 0.f, hm = 0.f;
    LAS float* X = (LAS float*)ldsw;
    bf16x8 uf = *(const bf16x8*)(Ub + (size_t)r32 * SW + 8 * hi);
    for (int ci = 0; ci < SEQ / 32; ++ci) {
        const int t0 = 32 * ci;
        bf16x8 ufn = uf;
        if (ci + 1 < SEQ / 32) ufn = *(const bf16x8*)(Ub + (size_t)(t0 + 32 + r32) * SW + 8 * hi);
        bf16_t uq[2][4];
#pragma unroll
        for (int rb = 0; rb < 2; ++rb)
#pragma unroll
            for (int j = 0; j < 4; ++j) uq[rb][j] = Ub[(size_t)(t0 + 16 * rb + 4 * fq + j) * SW + c16];
#pragma unroll
        for (int cb = 0; cb < 4; ++cb) {
            f32x16 acc = {};
            acc = __builtin_amdgcn_mfma_f32_32x32x16_bf16(uf, bfr[cb], acc, 0, 0, 0);
#pragma unroll
            for (int r = 0; r < 16; ++r) X[((r & 3) + 8 * (r >> 2) + 4 * hi) * S5_ROWF + 32 * cb + r32] = acc[r];
        }
        LDS_WAIT(); __syncthreads();
#pragma unroll 8
        for (int t = 0; t < 32; ++t) {
            const float xr = X[t * S5_ROWF + lane], xi = X[t * S5_ROWF + 64 + lane];
            const float nr = are * hr - aim * hm + xr, ni = are * hm + aim * hr + xi;
            hr = nr; hm = ni;
            LAS bf16_t* hrow = (LAS bf16_t*)(X + t * S5_ROWF);
            hrow[lane] = (bf16_t)f2bf(hr); hrow[64 + lane] = (bf16_t)f2bf(hm);
        }
        LDS_WAIT(); __syncthreads();
#pragma unroll
        for (int rb = 0; rb < 2; ++rb) {
            f32x4 a4 = {0.f, 0.f, 0.f, 0.f};
#pragma unroll
            for (int kk = 0; kk < 4; ++kk) {
                const bf16x8 af = *(const LAS bf16x8*)((LAS unsigned char*)ldsw + (16 * rb + c16) * (S5_ROWF * 4) + (32 * kk + 8 * fq) * 2);
                a4 = __builtin_amdgcn_mfma_f32_16x16x32_bf16(af, cfr[kk], a4, 0, 0, 0);
            }
#pragma unroll
            for (int j = 0; j < 4; ++j) { const int t = t0 + 16 * rb + 4 * fq + j;
                const float uval = __uint_as_float((unsigned)uq[rb][j] << 16);
                const float y = a4[j] + dv * uval;
                Gb[(size_t)t * SW + c16] = (bf16_t)f2bf(gelu_tanh(y)); }
        }
        LDS_WAIT(); __syncthreads();
        uf = ufn;
    }
}

__device__ __forceinline__ void moe_tables(Frame& F) {
    __syncthreads();
    if (F.wave == 0) {
        unsigned c = 0;
        if (F.lane < NE) c = __hip_atomic_load(F.ctl + CW_CNT + 64 * F.lane, __ATOMIC_RELAXED, __HIP_MEMORY_SCOPE_AGENT);
        c = c > (unsigned)T ? (unsigned)T : c;
        int nt = (int)((c + 255u) >> 8), incl = nt;
#pragma unroll
        for (int o = 1; o < 32; o <<= 1) { const int v = __shfl_up(incl, o); if (F.lane >= o) incl += v; }
        if (F.lane < NE) F.MISC[25 + F.lane] = (unsigned)incl;
        if (F.lane == 0) F.MISC[24] = 0u;
    }
    __syncthreads();
}
struct Args { const float* in[27]; float* out; unsigned char* ws; int ph_lo, ph_hi, li, pad; };
__global__ void __launch_bounds__(NWAVES * 64, 2) mk_fwd(Args args) {
    extern __shared__ __attribute__((aligned(16))) unsigned char lds[];
    Frame F;
    F.lds = (LAS unsigned char*)lds;
    F.MISC = (volatile LAS unsigned*)(F.lds + MISC_OFF);
    F.tid = threadIdx.x; F.lane = F.tid & 63; F.wave = __builtin_amdgcn_readfirstlane(F.tid >> 6);
    F.G = gridDim.x;
    unsigned char* ws = args.ws;
    F.ctl = (unsigned*)(ws + WS_CTL);
    const float* const* in = args.in;
    for (int u = F.tid; u < (LDS_BYTES - MISC_OFF) / 4; u += NWAVES * 64) ((LAS unsigned*)(F.lds + MISC_OFF))[u] = 0u;
    __syncthreads();
    XcdBarrier bar; bar.bar = F.ctl + CW_BAR; bar.x = 0; bar.st = nullptr;
    if (N_LAUNCHES == 1) bar = xcd_barrier_post(F.ctl + CW_BAR, F.MISC + 8);
#define GRID_BAR() do { if (N_LAUNCHES == 1) xcd_barrier(bar); } while (0)
    const int lo = args.ph_lo, hi = args.ph_hi;
#define IN(k) (lo <= (k) && (k) < hi)
    const int gw = (int)blockIdx.x * NWAVES + F.wave, NGW = F.G * NWAVES;
    bf16_t* const XN = (bf16_t*)(ws + WS_XN);
    bf16_t* const Qb = (bf16_t*)(ws + WS_Q); bf16_t* const Kb = (bf16_t*)(ws + WS_K); bf16_t* const Vb = (bf16_t*)(ws + WS_V); bf16_t* const Ub = (bf16_t*)(ws + WS_U);
    bf16_t* const AO = (bf16_t*)(ws + WS_AO); bf16_t* const GB = (bf16_t*)(ws + WS_G); bf16_t* const SB = (bf16_t*)(ws + WS_S); bf16_t* const MIX = (bf16_t*)(ws + WS_MIX);
    bf16_t* const H1 = (bf16_t*)(ws + WS_H1);
    bf16_t* const XN2T = (bf16_t*)(ws + WS_XG);
    unsigned char* const HID8 = ws + WS_HID; unsigned char* const XN8 = ws + WS_XN8; unsigned char* const Y8 = ws + WS_Y;
    int* const LIST = (int*)(ws + WS_LIST); int* const TOKE = (int*)(ws + WS_TOKE); int* const TOKP = (int*)(ws + WS_TOKP); float* const TOKG = (float*)(ws + WS_TOKG);
    const LAS int* tb = (const LAS int*)(F.lds + MISC_OFF + 24 * 4);

    if (IN(0)) { p0_prologue(F, in, ws); GRID_BAR(); }

    if (IN(1)) {
#ifndef NCONV_WG_
#define NCONV_WG_ 48
#endif
        constexpr int NCONV_WG = NCONV_WG_;
        const int GG = (NCONV_WG > 0 && F.G > 2 * NCONV_WG) ? F.G - NCONV_WG : F.G;
        if ((int)blockIdx.x < GG) {
            pg8::Gemm g{XN, (const bf16_t*)(ws + WS_WIN), T, INW, DM}; pg8::StaticOrder S; S.init(T, INW, GG, (int)blockIdx.x);
            pg8::EpiBf16<0> E{Qb, AW, nullptr, AW, (size_t)(WS_K - WS_Q) / 2, 1.0f};
            pg8::gemm_phase<pg8::EpiBf16<0>, pg8::StaticOrder, true, true>(F.lds + RING_OFF, g, S, E);
            if (F.tid == 0) __hip_atomic_fetch_add(F.ctl + CW_P1DONE, 1u, __ATOMIC_RELAXED, __HIP_MEMORY_SCOPE_AGENT);
        } else {
            for (;;) {
                if (F.tid == 0) { const unsigned dn = __hip_atomic_load(F.ctl + CW_P1DONE, __ATOMIC_RELAXED, __HIP_MEMORY_SCOPE_AGENT);
                    F.MISC[16] = dn >= (unsigned)GG ? 0xffffffffu : __hip_atomic_fetch_add(F.ctl + CW_QUEUE, 1u, __ATOMIC_RELAXED, __HIP_MEMORY_SCOPE_AGENT); }
                __syncthreads();
                const unsigned cu = F.MISC[16];
                __syncthreads();
                if (cu >= (unsigned)N_CONV_UNITS) break;
                conv_unit8(in, ws, (int)cu, F.wave, F.lane, (LAS unsigned*)(F.lds + RING_OFF + F.wave * CONV8_WAVE_BYTES));
            }
        }
        GRID_BAR();
    }

    if (IN(2)) {
        constexpr int N_S5U = NB * NG / NWAVES, N_ATU = NB * NH * (SEQ / 256);
        if ((int)blockIdx.x < N_S5U)
            s5_sequence((int)blockIdx.x * NWAVES + F.wave, Ub, GB, (const float*)(ws + WS_ABAR), (const bf16_t*)(ws + WS_TB), (const bf16_t*)(ws + WS_TC), in[11],
                        F.lds + RING_OFF + F.wave * S5_WAVE_BYTES, F.lane);
        __syncthreads();
#ifndef P2_ATTN_FIRST_
#define P2_ATTN_FIRST_ 48
#endif
        if ((int)blockIdx.x >= N_S5U && (int)blockIdx.x < F.G - P2_ATTN_FIRST_) {
            for (;;) {
                if (F.tid == 0) F.MISC[16] = __hip_atomic_fetch_add(F.ctl + CW_QUEUE, 1u, __ATOMIC_RELAXED, __HIP_MEMORY_SCOPE_AGENT);
                __syncthreads();
                const int cu = (int)F.MISC[16];
                __syncthreads();
                if (cu >= N_CONV_UNITS) break;
                conv_unit8(in, ws, (int)cu, F.wave, F.lane, (LAS unsigned*)(F.lds + RING_OFF + F.wave * CONV8_WAVE_BYTES));
            }
        }
        for (;;) {
            if (F.tid == 0) F.MISC[16] = __hip_atomic_fetch_add(F.ctl + CW_QUEUE + 64, 1u, __ATOMIC_RELAXED, __HIP_MEMORY_SCOPE_AGENT);
            __syncthreads();
            const int a = (int)F.MISC[16];
            __syncthreads();
            if (a >= N_ATU) break;
            const int qb = a & 7, h = (a >> 3) & 7, b = a >> 6;
            att::attn_unit(b, h, qb, (const att::bf16*)Qb, (const att::bf16*)Kb, (const att::bf16*)Vb, (att::bf16*)AO, in[3], (char*)lds + RING_OFF);
        }
        GRID_BAR();
    }

    if (IN(3)) {
        pg8::Gemm g{GB, (const bf16_t*)(ws + WS_WGLU), T, SW, SW}; pg8::StaticOrder S; S.init(T, SW, F.G, (int)blockIdx.x);
        pg8::EpiGlu E{GB, SB, SW, in[13]};
        pg8::gemm_phase<pg8::EpiGlu, pg8::StaticOrder, true, true>(F.lds + RING_OFF, g, S, E);
        GRID_BAR();
    }

    if (IN(4)) {
        for (int m = gw; m < T; m += NGW) {
#pragma unroll
            for (int half = 0; half < 2; ++half) {
                const bf16_t* src = (half ? SB : AO) + (size_t)m * AW; const float* gain = in[half ? 15 : 14];
                v4u w[2]; float s = 0.f;
#pragma unroll
                for (int j = 0; j < 2; ++j) { w[j] = *(const v4u*)(src + 8 * (F.lane + 64 * j));
#pragma unroll
                    for (int q = 0; q < 4; ++q) { const float a = bflo(w[j][q]), bq = bfhi(w[j][q]); s += a * a + bq * bq; } }
                const float r = 1.0f / sqrtf(wave_sum(s) * (1.0f / AW) + EPS);
#pragma unroll
                for (int j = 0; j < 2; ++j) { const int col = 8 * (F.lane + 64 * j); const f32x4 g0 = *(const f32x4*)(gain + col), g1 = *(const f32x4*)(gain + col + 4);
                    v4u o; o.x = pk2(bflo(w[j].x) * r * g0.x, bfhi(w[j].x) * r * g0.y); o.y = pk2(bflo(w[j].y) * r * g0.z, bfhi(w[j].y) * r * g0.w);
                    o.z = pk2(bflo(w[j].z) * r * g1.x, bfhi(w[j].z) * r * g1.y); o.w = pk2(bflo(w[j].w) * r * g1.z, bfhi(w[j].w) * r * g1.w);
                    *(v4u*)(MIX + (size_t)m * DM + half * AW + col) = o; }
            }
        }
        GRID_BAR();
    }

    if (IN(5)) {
        pg8::Gemm g{MIX, (const bf16_t*)(ws + WS_WOUT), T, DM, DM}; pg8::StaticOrder S; S.init(T, DM, F.G, (int)blockIdx.x);
        pg8::EpiResBf16 E{in[0], H1, DM};
        pg8::gemm_phase<pg8::EpiResBf16, pg8::StaticOrder, true, true>(F.lds + RING_OFF, g, S, E);
        GRID_BAR();
    }

    if (IN(6)) {
        constexpr int N2S = 2052;
        LAS float* n2s = (LAS float*)(F.lds + RING_OFF);
        static_assert(16 * N2S * 4 <= RING_BYTES, "router tile");
        for (int pass = (int)blockIdx.x; pass < T / 16; pass += F.G) {
#pragma unroll 1
            for (int rr = 0; rr < 2; ++rr) {
                const int lr = 2 * F.wave + rr, row = 16 * pass + lr;
                const bf16_t* xrow = H1 + (size_t)row * DM;
                f32x4 v[8]; float s = 0.f;
#pragma unroll
                for (int j = 0; j < 8; ++j) { const v2u w = *(const v2u*)(xrow + 4 * (F.lane + 64 * j)); v[j] = (f32x4){bflo(w.x), bfhi(w.x), bflo(w.y), bfhi(w.y)};
                    s += (v[j].x * v[j].x + v[j].y * v[j].y) + (v[j].z * v[j].z + v[j].w * v[j].w); }
                const float r = 1.0f / sqrtf(wave_sum(s) * (1.0f / DM) + EPS);
#pragma unroll
                for (int j = 0; j < 8; ++j) { const int col = 4 * (F.lane + 64 * j); const f32x4 g = *(const f32x4*)(in[17] + col);
                    const f32x4 n = {v[j].x * r * g.x, v[j].y * r * g.y, v[j].z * r * g.z, v[j].w * r * g.w};
                    *(LAS f32x4*)(n2s + lr * N2S + col) = n;
                    *(unsigned*)(XN8 + (size_t)row * DM + col) = pg8::pk4_fp8(n.x, n.y, n.z, n.w); }
            }
            __syncthreads();
            f32x4 lg0 = {0.f, 0.f, 0.f, 0.f}, lg1 = {0.f, 0.f, 0.f, 0.f};
            {
                const int c16 = F.lane & 15, kq = F.lane >> 4;
                const LAS float* ap = n2s + c16 * N2S + 256 * F.wave + kq;
                const float* bp = in[18] + (size_t)(256 * F.wave + kq) * NE + c16;
#pragma unroll 8
                for (int s4 = 0; s4 < 64; ++s4) {
                    const float av = ap[4 * s4]; const float b0 = bp[(size_t)(4 * s4) * NE], b1 = bp[(size_t)(4 * s4) * NE + 16];
                    lg0 = __builtin_amdgcn_mfma_f32_16x16x4f32(av, b0, lg0, 0, 0, 0);
                    lg1 = __builtin_amdgcn_mfma_f32_16x16x4f32(av, b1, lg1, 0, 0, 0);
                }
            }
            __syncthreads();
            {
                const int c16 = F.lane & 15, tq = F.lane >> 4;
#pragma unroll
                for (int j = 0; j < 4; ++j) { n2s[(F.wave * 16 + 4 * tq + j) * 32 + c16] = lg0[j]; n2s[(F.wave * 16 + 4 * tq + j) * 32 + 16 + c16] = lg1[j]; }
            }
            __syncthreads();
            {
                const int tl = F.tid >> 5, e = F.tid & 31, token = 16 * pass + tl;
                float val = in[19][e];
#pragma unroll
                for (int w = 0; w < NWAVES; ++w) val += n2s[(w * 16 + tl) * 32 + e];
                float tv0 = 0.f, tv1 = 0.f, tv2 = 0.f, tv3 = 0.f; int ti0 = 0, ti1 = 0, ti2 = 0, ti3 = 0;
#pragma unroll
                for (int k = 0; k < 4; ++k) {
                    float bv = val; int bi = e;
#pragma unroll
                    for (int off = 16; off >= 1; off >>= 1) { const float ov = __shfl_xor(bv, off); const int oi = __shfl_xor(bi, off); if (ov > bv || (ov == bv && oi < bi)) { bv = ov; bi = oi; } }
                    if (k == 0) { tv0 = bv; ti0 = bi; } else if (k == 1) { tv1 = bv; ti1 = bi; } else if (k == 2) { tv2 = bv; ti2 = bi; } else { tv3 = bv; ti3 = bi; }
                    if (e == bi) val = -INFINITY;
                }
                const float e0 = 1.0f, e1 = __expf(tv1 - tv0), e2 = __expf(tv2 - tv0), e3 = __expf(tv3 - tv0), inv = 1.0f / (e0 + e1 + e2 + e3);
                if (e < 4) {
                    const int ek = e == 0 ? ti0 : (e == 1 ? ti1 : (e == 2 ? ti2 : ti3));
                    const float gk = (e == 0 ? e0 : (e == 1 ? e1 : (e == 2 ? e2 : e3))) * inv;
                    const unsigned pos = __hip_atomic_fetch_add(F.ctl + CW_CNT + 64 * ek, 1u, __ATOMIC_RELAXED, __HIP_MEMORY_SCOPE_AGENT);
                    if (pos < (unsigned)T) LIST[(size_t)ek * T + pos] = token;
                    TOKE[token * 4 + e] = ek; TOKP[token * 4 + e] = (int)pos; TOKG[token * 4 + e] = gk;
                }
            }
            __syncthreads();
        }
        GRID_BAR();
    }

    if (IN(8)) {
        moe_tables(F);
        pg8::Gemm g{(const bf16_t*)XN8, (const bf16_t*)(ws + WS_WGU), 0, 0, DM / 2, LIST, tb, 4, T}; pg8::MoeOrder S{tb, 16, F.G, (int)blockIdx.x};
        pg8::EpiSwiglu8 E{HID8, DFF, in[21], in[23]};
        pg8::gemm_phase<pg8::EpiSwiglu8, pg8::MoeOrder, true, true, true, true>(F.lds + RING_OFF, g, S, E);
        GRID_BAR();
    }

    if (IN(9)) {
        moe_tables(F);
        pg8::Gemm g{(const bf16_t*)HID8, (const bf16_t*)(ws + WS_WD), 0, 0, DFF / 2}; pg8::MoeOrder S{tb, 8, F.G, (int)blockIdx.x};
        pg8::EpiFp8 E{Y8, DM, in[25], DM};
        pg8::gemm_phase<pg8::EpiFp8, pg8::MoeOrder, true, true, true>(F.lds + RING_OFF, g, S, E);
        GRID_BAR();
    }

    if (IN(10)) {
        moe_tables(F);
        for (int m = gw; m < T; m += NGW) {
            f32x4 v[8];
#pragma unroll
            for (int j = 0; j < 8; ++j) { const v2u w = *(const v2u*)(H1 + (size_t)m * DM + 4 * (F.lane + 64 * j)); v[j] = (f32x4){bflo(w.x), bfhi(w.x), bflo(w.y), bfhi(w.y)}; }
#pragma unroll
            for (int k = 0; k < 4; ++k) { const int ek = TOKE[m * 4 + k], pk = TOKP[m * 4 + k]; const float gk = TOKG[m * 4 + k]; const unsigned char* y = Y8 + ((size_t)tb[ek] * 256 + pk) * DM;
#pragma unroll
                for (int j = 0; j < 8; ++j) { const unsigned w = *(const unsigned*)(y + 4 * (F.lane + 64 * j));
                    const f32x2 lo = __builtin_amdgcn_cvt_pk_f32_fp8((int)w, false), hi2 = __builtin_amdgcn_cvt_pk_f32_fp8((int)w, true);
                    v[j].x += gk * lo[0]; v[j].y += gk * lo[1]; v[j].z += gk * hi2[0]; v[j].w += gk * hi2[1]; } }
            float s = 0.f;
#pragma unroll
            for (int j = 0; j < 8; ++j) s += (v[j].x * v[j].x + v[j].y * v[j].y) + (v[j].z * v[j].z + v[j].w * v[j].w);
            const float r = 1.0f / sqrtf(wave_sum(s) * (1.0f / DM) + EPS);
#pragma unroll
            for (int j = 0; j < 8; ++j) { const int col = 4 * (F.lane + 64 * j); const f32x4 g = *(const f32x4*)(in[26] + col);
                *(f32x4*)(args.out + (size_t)m * DM + col) = (f32x4){v[j].x * r * g.x, v[j].y * r * g.y, v[j].z * r * g.z, v[j].w * r * g.w}; }
        }
    }
#undef IN
#undef GRID_BAR
}

extern "C" void kernel_launch(void* const* d_in, const int* in_sizes, int n_in, void* d_out, int out_size, void* d_ws, size_t ws_size, hipStream_t stream) {
    static int grid = 0;
    if (grid == 0) {
        if (n_in != 27 || in_sizes[0] != T * DM || out_size != T * DM || ws_size < WS_END) {
            fprintf(stderr, "kernel_launch: shape/workspace mismatch: n_in %d in0 %d out %d ws %zu (need %zu); nothing launched\n", n_in, n_in > 0 ? in_sizes[0] : -1, out_size, ws_size, (size_t)WS_END); grid = -1; return; }
        int dev = 0, cus = 0, per_cu = 0;
        if (hipGetDevice(&dev) != hipSuccess || hipDeviceGetAttribute(&cus, hipDeviceAttributeMultiprocessorCount, dev) != hipSuccess) { fprintf(stderr, "kernel_launch: device query failed\n"); grid = -1; return; }
        if (hipFuncSetAttribute((const void*)mk_fwd, hipFuncAttributeMaxDynamicSharedMemorySize, LDS_BYTES) != hipSuccess) { fprintf(stderr, "kernel_launch: hipFuncSetAttribute failed\n"); grid = -1; return; }
        if (hipOccupancyMaxActiveBlocksPerMultiprocessor(&per_cu, (const void*)mk_fwd, NWAVES * 64, LDS_BYTES) != hipSuccess || per_cu < 1)
            fprintf(stderr, "kernel_launch: note: occupancy query reports %d workgroups per CU\n", per_cu);
        (void)hipGetLastError();
        grid = cus;
    }
    if (grid < 0) return;
    if (hipMemsetAsync((char*)d_ws + WS_CTL, 0, CTL_ZERO_BYTES, stream) != hipSuccess) { fprintf(stderr, "kernel_launch: memset failed\n"); return; }
    Args a{};
    for (int i = 0; i < 27; ++i) a.in[i] = (const float*)d_in[i];
    a.out = (float*)d_out; a.ws = (unsigned char*)d_ws; a.pad = 0;
    for (int li = 0; li < N_LAUNCHES; ++li) {
        a.ph_lo = (N_LAUNCHES == 1) ? 0 : li; a.ph_hi = (N_LAUNCHES == 1) ? NPH : li + 1; a.li = li;
        hipLaunchKernelGGL(mk_fwd, dim3(grid), dim3(NWAVES * 64), LDS_BYTES, stream, a);
        const hipError_t le = hipPeekAtLastError();
        if (le != hipSuccess) { fprintf(stderr, "kernel_launch: launch %d failed: %s\n", li, hipGetErrorName(le)); break; }
    }
}
```

```cpp
#include <hip/hip_runtime.h>
#include <hip/hip_bf16.h>
#include <cstdio>
#include <cstdint>
#include <cmath>
namespace pg8 {
#define PG8_LAS __attribute__((address_space(3)))
typedef unsigned short bf16_t;
typedef short bf16x8 __attribute__((ext_vector_type(8)));
typedef float f32x4 __attribute__((ext_vector_type(4)));
typedef unsigned u32x4 __attribute__((ext_vector_type(4)));
constexpr int BM = 256, BK = 64, HALF = 128, HTB = HALF * BK * 2  , STAGE_BYTES = 8 * HTB, NXCD = 8, WGM = 8;

__host__ __device__ __forceinline__ int lds_byte(int r, int c) { const int st = (r >> 4) * 2 + (c >> 5), rr = r & 15, cc = c & 31, ob = rr * 64 + cc * 2; return st * 1024 + (ob ^ (((ob >> 9) & 1) << 5)); }
__host__ __device__ __forceinline__ void stage_rc(int b, int& R, int& C) { const int st = b / 1024, sb = b % 1024, swz = sb ^ (((sb >> 9) & 1) << 5); R = (st >> 1) * 16 + swz / 64; C = (st & 1) * 32 + (swz % 64) / 2; }
__host__ __device__ __forceinline__ int perm32(int rho) { const int n = rho >> 4, i = rho & 15; return 8 * (i >> 2) + 4 * n + (i & 3); }

struct Unit { int pm, pn; };
struct Gemm { const bf16_t* A; const bf16_t* Bt; int M, N, K;
    const int* glist = nullptr; const PG8_LAS int* gtb = nullptr; int gshift = 0, gT = 0; };

struct StaticOrder {
    int nM, nN, nwg, G, c;
    __host__ __device__ void init(int M, int N, int G_, int c_) { nM = M / BM; nN = N / BM; nwg = nM * nN; G = G_; c = c_; }
    __host__ __device__ bool next(int i, Unit& u) const {
        const long L = (long)i * G + c; if (L >= nwg) return false;
        int wgid = (int)L; { const int q = nwg / NXCD, r = nwg % NXCD, xcd = wgid % NXCD, off = wgid / NXCD; wgid = (xcd < r ? xcd * (q + 1) : r * (q + 1) + (xcd - r) * q) + off; }
        const int nig = WGM * nN, gid = wgid / nig, fm = gid * WGM, gsz = (nM - fm) < WGM ? (nM - fm) : WGM;
        u.pm = fm + ((wgid % nig) % gsz); u.pn = (wgid % nig) / gsz; return true;
    }
    __device__ __forceinline__ void a_ready(const Unit&) const {}
    __device__ __forceinline__ void done(const Unit&) const {}
};

__device__ __forceinline__ unsigned cvt_pk_bf16(float lo, float hi) { unsigned r; asm volatile("v_cvt_pk_bf16_f32 %0, %1, %2" : "=v"(r) : "v"(lo), "v"(hi)); return r; }
typedef float f32x2 __attribute__((ext_vector_type(2)));
__device__ __forceinline__ f32x2 gelu_pk(f32x2 v) {
    const f32x2 av = __builtin_elementwise_abs(v), d = av * 0.2316418882f + 1.0f;
    f32x2 t; t.x = __builtin_amdgcn_rcpf(d.x); t.y = __builtin_amdgcn_rcpf(d.y);
    f32x2 q = t * 0.5307027145f + (-0.7265760135f); q = q * t + 0.7107068705f; q = q * t + (-0.142248368f); q = q * t + 0.127414796f; q = q * t;
    const f32x2 s = (v * v) * (-0.72134752044f);
    f32x2 e; e.x = __builtin_amdgcn_exp2f(s.x); e.y = __builtin_amdgcn_exp2f(s.y);
    const f32x2 m = v * (q * e), r = v - m;
    f32x2 o; o.x = v.x < 0.f ? m.x : r.x; o.y = v.y < 0.f ? m.y : r.y; return o;
}

template <int ACT  > struct EpiBf16 {
    static constexpr bool PERM = true, AFTER_DRAIN = false; static_assert(ACT == 0 || ACT == 1, "EpiBf16: ACT is 0 (none) or 1 (gelu_pk)");
    bf16_t* O; int ldc; const float* bias; int split_cols; size_t split_stride; float scale0;
    __device__ __forceinline__ void operator()(const f32x4 (&acc)[2][2][4][2], const Unit& u, int wr, int wc, int fr, int fq) const {
        const int row0 = u.pm * BM + wr * 64 + fr; int colt = u.pn * BM; bf16_t* base = O;
        float sc = 1.f; if (split_cols) { const int t = colt / split_cols; base += (size_t)t * split_stride; colt -= t * split_cols; if (t == 0) sc = scale0; }
        const int col0 = colt + wc * 32 + 8 * fq, bcol0 = u.pn * BM + wc * 32 + 8 * fq;
        f32x4 bv[2][2];
#pragma unroll
        for (int bj = 0; bj < 2; ++bj)
#pragma unroll
            for (int n = 0; n < 2; ++n) bv[bj][n] = bias ? *(const f32x4*)(bias + bcol0 + bj * HALF + 4 * n) : (f32x4){0.f, 0.f, 0.f, 0.f};
#pragma unroll
        for (int ai = 0; ai < 2; ++ai)
#pragma unroll
            for (int m = 0; m < 4; ++m) { bf16_t* rowp = base + (size_t)(row0 + ai * HALF + m * 16) * ldc + col0;
#pragma unroll
                for (int bj = 0; bj < 2; ++bj) { f32x4 v0 = acc[ai][bj][m][0] + bv[bj][0], v1 = acc[ai][bj][m][1] + bv[bj][1];
                    if (ACT == 1) { f32x2 a = gelu_pk((f32x2){v0[0], v0[1]}), b = gelu_pk((f32x2){v0[2], v0[3]}), c = gelu_pk((f32x2){v1[0], v1[1]}), d = gelu_pk((f32x2){v1[2], v1[3]});
                        v0 = (f32x4){a.x, a.y, b.x, b.y}; v1 = (f32x4){c.x, c.y, d.x, d.y}; }
                    v0 = v0 * sc; v1 = v1 * sc; u32x4 w; w.x = cvt_pk_bf16(v0[0], v0[1]); w.y = cvt_pk_bf16(v0[2], v0[3]); w.z = cvt_pk_bf16(v1[0], v1[1]); w.w = cvt_pk_bf16(v1[2], v1[3]);
                    *(u32x4*)(rowp + bj * HALF) = w; } }
    }
};
typedef int v8i_t __attribute__((ext_vector_type(8)));
typedef int v4i_t __attribute__((ext_vector_type(4)));
__device__ __forceinline__ v8i_t cat8(bf16x8 a, bf16x8 b) { const v4i_t x = __builtin_bit_cast(v4i_t, a), y = __builtin_bit_cast(v4i_t, b); return (v8i_t){x[0], x[1], x[2], x[3], y[0], y[1], y[2], y[3]}; }
__device__ __forceinline__ void mfma8_inplace(f32x4& c, v8i_t a, v8i_t b, int sa, int sb) {
    asm volatile("v_mfma_scale_f32_16x16x128_f8f6f4 %0, %1, %2, %0, %3, %4 op_sel_hi:[0,0,0]" : "+v"(c) : "v"(a), "v"(b), "v"(sa), "v"(sb)); }
template <class Epi, class Sched, bool ALIGN_EPI = false, bool SP2 = false, bool FP8 = false, bool GATHER = false>
__device__ __forceinline__ void gemm_phase(PG8_LAS unsigned char* lds, const Gemm g, const Sched& S, const Epi& E) {
    const int tid = threadIdx.x, wid = __builtin_amdgcn_readfirstlane(tid >> 6), lane = tid & 63, wr = wid >> 2, wc = wid & 3, fr = lane & 15, fq = lane >> 4;
    const int K = g.K, nt = K / BK;
    int sc_w = 0x7a7a7a7a, sc_a = 0x7f7f7f7f; if constexpr (FP8) { asm volatile("" : "+v"(sc_w), "+v"(sc_a)); }
    unsigned voffA[2], voffB[2]; int Ri[2]; unsigned Cb[2];
#pragma unroll
    for (int i = 0; i < 2; ++i) { int R, C; stage_rc(tid * 16 + i * 8192, R, C); const int Rb = Epi::PERM ? ((R & ~31) + perm32(R & 31)) : R;
        voffA[i] = (unsigned)(R * K + C) * 2u; voffB[i] = (unsigned)(Rb * K + C) * 2u; Ri[i] = R; Cb[i] = (unsigned)C * 2u; }
    unsigned gc[2][2] = {{0u, 0u}, {0u, 0u}}, gn[2][2] = {{0u, 0u}, {0u, 0u}}; int tkn[2][2] = {{0, 0}, {0, 0}};
    const size_t kstep = (size_t)(BK * 2);
    const size_t hstep = (size_t)HALF * K * 2;
    const size_t tstep = 2 * hstep;
    const unsigned ldsw = (unsigned)wid * 1024u;
    const int aoff = lds_byte(wr * 64 + fr, fq * 8), boff = lds_byte(wc * 32 + fr, fq * 8);
#define PG8_SA(b, h) (((b) * 2 + (h)) * HTB)
#define PG8_SB(b, h) ((4 + (b) * 2 + (h)) * HTB)
#define PG8_STAGE(bufoff, gbase, voff) do { _Pragma("unroll") for (int _i = 0; _i < 2; ++_i) \
        __builtin_amdgcn_global_load_lds((const unsigned*)((const char*)(gbase) + (voff)[_i]), (PG8_LAS unsigned*)(lds + (bufoff) + ldsw + _i * 8192), 16, 0, 0); } while (0)
#define PG8_TOK(u, tk) do { const int e_ = (u).pn >> g.gshift; const int* lp_ = g.glist + (size_t)e_ * g.gT + ((u).pm - g.gtb[e_]) * BM; \
        _Pragma("unroll") for (int h_ = 0; h_ < 2; ++h_) _Pragma("unroll") for (int i_ = 0; i_ < 2; ++i_) tk[h_][i_] = lp_[h_ * HALF + Ri[i_]]; } while (0)
#define PG8_GOFF(tk, go) do { _Pragma("unroll") for (int h_ = 0; h_ < 2; ++h_) _Pragma("unroll") for (int i_ = 0; i_ < 2; ++i_) { const int t_ = (unsigned)tk[h_][i_] < (unsigned)g.gT ? tk[h_][i_] : 0; \
        go[h_][i_] = (unsigned)t_ * (unsigned)(K * 2) + Cb[i_]; } } while (0)
#define PG8_STAGE_A(bufoff, ptr, h, nx) do { if constexpr (GATHER) { unsigned vo_[2]; vo_[0] = (nx) ? gn[h][0] : gc[h][0]; vo_[1] = (nx) ? gn[h][1] : gc[h][1]; PG8_STAGE(bufoff, ptr, vo_); } \
        else { PG8_STAGE(bufoff, (ptr) + ((h) ? hstep : (size_t)0), voffA); } } while (0)
#define PG8_LDA(dst, b, h) do { _Pragma("unroll") for (int m = 0; m < 4; ++m) _Pragma("unroll") for (int k = 0; k < 2; ++k) dst[m][k] = *(const PG8_LAS bf16x8*)(lds + PG8_SA(b, h) + aoff + m * 2048 + k * 1024); } while (0)
#define PG8_LDB(dst, b, h) do { _Pragma("unroll") for (int n = 0; n < 2; ++n) _Pragma("unroll") for (int k = 0; k < 2; ++k) dst[n][k] = *(const PG8_LAS bf16x8*)(lds + PG8_SB(b, h) + boff + n * 2048 + k * 1024); } while (0)
#define PG8_MMA(ai, bj, At, Bt) do { __builtin_amdgcn_s_setprio(1); if constexpr (FP8) { _Pragma("unroll") for (int m = 0; m < 4; ++m) _Pragma("unroll") for (int n = 0; n < 2; ++n) \
        mfma8_inplace(acc[ai][bj][m][n], cat8(Bt[n][0], Bt[n][1]), cat8(At[m][0], At[m][1]), sc_w, sc_a); } else { \
        _Pragma("unroll") for (int m = 0; m < 4; ++m) _Pragma("unroll") for (int n = 0; n < 2; ++n) _Pragma("unroll") for (int k = 0; k < 2; ++k) \
        acc[ai][bj][m][n] = __builtin_amdgcn_mfma_f32_16x16x32_bf16(Bt[n][k], At[m][k], acc[ai][bj][m][n], 0, 0, 0); } __builtin_amdgcn_s_setprio(0); } while (0)
#define PG8_WAIT_V(n) asm volatile("s_waitcnt vmcnt(" #n ")" ::: "memory")
#define PG8_WAIT_L(n) asm volatile("s_waitcnt lgkmcnt(" #n ")" ::: "memory")
#define PG8_BAR __builtin_amdgcn_s_barrier()
#define PG8_SCHED __builtin_amdgcn_sched_barrier(0)
    Unit cur, nxt; int ui = 0;
    if (!S.next(0, cur)) return;
    f32x4 acc[2][2][4][2];
#pragma unroll
    for (int a = 0; a < 2; ++a)
#pragma unroll
        for (int b = 0; b < 2; ++b)
#pragma unroll
            for (int m = 0; m < 4; ++m)
#pragma unroll
                for (int n = 0; n < 2; ++n) acc[a][b][m][n] = (f32x4){0.f, 0.f, 0.f, 0.f};
    bf16x8 At[4][2], B0[2][2], B1[2][2];
    const char* cA = (const char*)g.A + (GATHER ? (size_t)0 : (size_t)cur.pm * tstep); const char* cB = (const char*)g.Bt + (size_t)cur.pn * tstep;
    if constexpr (GATHER) { PG8_TOK(cur, tkn); PG8_GOFF(tkn, gc); Unit n1_; if (S.next(1, n1_)) PG8_TOK(n1_, tkn); }
    S.a_ready(cur);
    if constexpr (SP2) {
        PG8_STAGE(PG8_SB(0, 0), cB, voffB); PG8_STAGE(PG8_SB(0, 1), cB + hstep, voffB); PG8_STAGE_A(PG8_SA(0, 0), cA, 0, false); PG8_STAGE_A(PG8_SA(0, 1), cA, 1, false);
        if (wr == 1) PG8_BAR;
        PG8_WAIT_V(2); PG8_BAR;
        PG8_STAGE(PG8_SB(1, 0), cB + kstep, voffB); PG8_STAGE_A(PG8_SA(1, 0), cA + kstep, 0, false); PG8_STAGE(PG8_SB(1, 1), cB + hstep + kstep, voffB);
        PG8_WAIT_V(6); PG8_BAR;
    } else {
        PG8_STAGE(PG8_SB(0, 0), cB, voffB); PG8_STAGE_A(PG8_SA(0, 0), cA, 0, false); PG8_STAGE(PG8_SB(0, 1), cB + hstep, voffB); PG8_STAGE_A(PG8_SA(0, 1), cA, 1, false);
        if (wr == 1) PG8_BAR;
        PG8_WAIT_V(4); PG8_BAR;
        PG8_STAGE(PG8_SB(1, 0), cB + kstep, voffB); PG8_STAGE_A(PG8_SA(1, 0), cA + kstep, 0, false); PG8_STAGE(PG8_SB(1, 1), cB + hstep + kstep, voffB);
        PG8_WAIT_V(6); PG8_BAR;
    }
    for (;;) {
        const bool has_next = S.next(ui + 1, nxt);
        const char* nA = (has_next && !GATHER) ? (const char*)g.A + (size_t)nxt.pm * tstep : cA; const char* nB = has_next ? (const char*)g.Bt + (size_t)nxt.pn * tstep : cB;
        if constexpr (GATHER) { if (has_next) { PG8_GOFF(tkn, gn); } else { gn[0][0] = gc[0][0]; gn[0][1] = gc[0][1]; gn[1][0] = gc[1][0]; gn[1][1] = gc[1][1]; }
            Unit n2_; if (S.next(ui + 2, n2_)) PG8_TOK(n2_, tkn); }
        for (int t = 0; t < nt; t += 2) {
            const bool last = (t == nt - 2);
            const char* a1 = cA + (size_t)(t + 1) * kstep;
            const char* a2 = last ? nA : cA + (size_t)(t + 2) * kstep; const char* b2 = last ? nB : cB + (size_t)(t + 2) * kstep;
            const char* a3 = a2 + kstep; const char* b3 = b2 + kstep;
            if (last && has_next) S.a_ready(nxt);
            if constexpr (SP2) {
            PG8_LDB(B0, 0, 0); PG8_LDB(B1, 0, 1); PG8_SCHED; PG8_LDA(At, 0, 0); PG8_STAGE_A(PG8_SA(1, 1), a1, 1, false);
            PG8_WAIT_V(8); PG8_WAIT_L(0); PG8_BAR; PG8_MMA(0, 0, At, B0); PG8_MMA(0, 1, At, B1); PG8_BAR; PG8_SCHED;
            PG8_LDA(At, 0, 1); PG8_STAGE(PG8_SB(0, 0), b2, voffB); PG8_STAGE(PG8_SB(0, 1), b2 + hstep, voffB); PG8_STAGE_A(PG8_SA(0, 0), a2, 0, last);
            PG8_WAIT_V(8); PG8_WAIT_L(0); PG8_BAR; PG8_MMA(1, 0, At, B0); PG8_MMA(1, 1, At, B1); PG8_BAR; PG8_SCHED;
            PG8_LDB(B0, 1, 0); PG8_LDB(B1, 1, 1); PG8_SCHED; PG8_LDA(At, 1, 0); PG8_STAGE_A(PG8_SA(0, 1), a2, 1, last);
            PG8_WAIT_V(8); PG8_WAIT_L(0); PG8_BAR; PG8_MMA(0, 0, At, B0); PG8_MMA(0, 1, At, B1); PG8_BAR; PG8_SCHED;
            PG8_LDA(At, 1, 1); PG8_STAGE(PG8_SB(1, 0), b3, voffB); PG8_STAGE(PG8_SB(1, 1), b3 + hstep, voffB); PG8_STAGE_A(PG8_SA(1, 0), a3, 0, last);
            PG8_WAIT_V(8); PG8_WAIT_L(0); PG8_BAR; PG8_MMA(1, 0, At, B0); PG8_MMA(1, 1, At, B1); PG8_BAR; PG8_SCHED;
            } else {
            PG8_LDB(B0, 0, 0); PG8_SCHED; PG8_LDA(At, 0, 0); PG8_STAGE_A(PG8_SA(1, 1), a1, 1, false);
            PG8_WAIT_L(8); PG8_BAR; PG8_WAIT_L(0); PG8_MMA(0, 0, At, B0); PG8_BAR; PG8_SCHED;
            PG8_LDB(B1, 0, 1); PG8_STAGE(PG8_SB(0, 0), b2, voffB);
            PG8_BAR; PG8_WAIT_L(0); PG8_MMA(0, 1, At, B1); PG8_BAR;
            PG8_LDA(At, 0, 1); PG8_STAGE_A(PG8_SA(0, 0), a2, 0, last);
            PG8_BAR; PG8_WAIT_L(0); PG8_MMA(1, 0, At, B0); PG8_BAR; PG8_SCHED;
            PG8_STAGE(PG8_SB(0, 1), b2 + hstep, voffB);
            PG8_WAIT_V(6); PG8_BAR; PG8_MMA(1, 1, At, B1); PG8_BAR;
            PG8_LDB(B0, 1, 0); PG8_SCHED; PG8_LDA(At, 1, 0); PG8_STAGE_A(PG8_SA(0, 1), a2, 1, last);
            PG8_WAIT_L(8); PG8_BAR; PG8_WAIT_L(0); PG8_MMA(0, 0, At, B0); PG8_BAR; PG8_SCHED;
            PG8_LDB(B1, 1, 1); PG8_STAGE(PG8_SB(1, 0), b3, voffB);
            PG8_BAR; PG8_WAIT_L(0); PG8_MMA(0, 1, At, B1); PG8_BAR;
            PG8_LDA(At, 1, 1); PG8_STAGE_A(PG8_SA(1, 0), a3, 0, last);
            PG8_BAR; PG8_WAIT_L(0); PG8_MMA(1, 0, At, B0); PG8_BAR; PG8_SCHED;
            PG8_STAGE(PG8_SB(1, 1), b3 + hstep, voffB);
            PG8_WAIT_V(6); PG8_BAR; PG8_MMA(1, 1, At, B1); PG8_BAR;
            }
        }
        if constexpr (FP8) asm volatile("s_nop 15\n\ts_nop 15" ::: "memory");
        if constexpr (ALIGN_EPI) { if (wr == 0) PG8_BAR; }
        if constexpr (!Epi::AFTER_DRAIN) { E(acc, cur, wr, wc, fr, fq); S.done(cur); }
        if (!has_next) break;
#pragma unroll
        for (int a = 0; a < 2; ++a)
#pragma unroll
            for (int b = 0; b < 2; ++b)
#pragma unroll
                for (int m = 0; m < 4; ++m)
#pragma unroll
                    for (int n = 0; n < 2; ++n) acc[a][b][m][n] = (f32x4){0.f, 0.f, 0.f, 0.f};
        cur = nxt; cA = nA; cB = nB; ++ui;
        if constexpr (GATHER) { gc[0][0] = gn[0][0]; gc[0][1] = gn[0][1]; gc[1][0] = gn[1][0]; gc[1][1] = gn[1][1]; }
        if constexpr (ALIGN_EPI) { if (wr == 1) PG8_BAR; }
    }
    PG8_WAIT_V(0);
    if constexpr (!ALIGN_EPI) { if (wr == 0) PG8_BAR; }
    PG8_BAR;
    if constexpr (Epi::AFTER_DRAIN) { E.fused(acc, cur, wr, wc, fr, fq, lds, wid, lane); S.done(cur); }
#undef PG8_TOK
#undef PG8_GOFF
#undef PG8_STAGE_A
#undef PG8_SA
#undef PG8_SB
#undef PG8_STAGE
#undef PG8_LDA
#undef PG8_LDB
#undef PG8_MMA
#undef PG8_WAIT_V
#undef PG8_WAIT_L
#undef PG8_BAR
#undef PG8_SCHED
}
__device__ __forceinline__ float bf_lo(unsigned w) { return __uint_as_float(w << 16); }
__device__ __forceinline__ float bf_hi(unsigned w) { return __uint_as_float(w & 0xffff0000u); }
__device__ __forceinline__ float sigmoidf_(float x) { return __builtin_amdgcn_rcpf(1.0f + __expf(-x)); }
struct EpiGlu {
    static constexpr bool PERM = true, AFTER_DRAIN = false;
    const bf16_t* G; bf16_t* O; int ldc; const float* bias;
    __device__ __forceinline__ void operator()(const f32x4 (&acc)[2][2][4][2], const Unit& u, int wr, int wc, int fr, int fq) const {
        const int row0 = u.pm * BM + wr * 64 + fr, col0 = u.pn * BM + wc * 32 + 8 * fq;
        f32x4 bv[2][2];
#pragma unroll
        for (int bj = 0; bj < 2; ++bj)
#pragma unroll
            for (int n = 0; n < 2; ++n) bv[bj][n] = *(const f32x4*)(bias + col0 + bj * HALF + 4 * n);
#pragma unroll
        for (int ai = 0; ai < 2; ++ai)
#pragma unroll
            for (int m = 0; m < 4; ++m) { const size_t ro = (size_t)(row0 + ai * HALF + m * 16) * ldc + col0;
#pragma unroll
                for (int bj = 0; bj < 2; ++bj) { const f32x4 v0 = acc[ai][bj][m][0] + bv[bj][0], v1 = acc[ai][bj][m][1] + bv[bj][1];
                    const u32x4 g = *(const u32x4*)(G + ro + bj * HALF);
                    const float o0 = bf_lo(g.x) * sigmoidf_(v0[0]), o1 = bf_hi(g.x) * sigmoidf_(v0[1]), o2 = bf_lo(g.y) * sigmoidf_(v0[2]), o3 = bf_hi(g.y) * sigmoidf_(v0[3]);
                    const float o4 = bf_lo(g.z) * sigmoidf_(v1[0]), o5 = bf_hi(g.z) * sigmoidf_(v1[1]), o6 = bf_lo(g.w) * sigmoidf_(v1[2]), o7 = bf_hi(g.w) * sigmoidf_(v1[3]);
                    u32x4 w; w.x = cvt_pk_bf16(o0, o1); w.y = cvt_pk_bf16(o2, o3); w.z = cvt_pk_bf16(o4, o5); w.w = cvt_pk_bf16(o6, o7);
                    *(u32x4*)(O + ro + bj * HALF) = w; } }
    }
};
struct EpiResF32 {
    static constexpr bool PERM = false, AFTER_DRAIN = false;
    const float* base; float* out; int ldc;
    __device__ __forceinline__ void operator()(const f32x4 (&acc)[2][2][4][2], const Unit& u, int wr, int wc, int fr, int fq) const {
        const int col0 = u.pn * BM + wc * 32 + 4 * fq;
#pragma unroll
        for (int ai = 0; ai < 2; ++ai)
#pragma unroll
            for (int m = 0; m < 4; ++m) { const size_t off = (size_t)(u.pm * BM + ai * HALF + wr * 64 + m * 16 + fr) * ldc + col0;
#pragma unroll
                for (int bj = 0; bj < 2; ++bj)
#pragma unroll
                    for (int n = 0; n < 2; ++n) { const f32x4 bs = *(const f32x4*)(base + off + bj * HALF + n * 16); *(f32x4*)(out + off + bj * HALF + n * 16) = bs + acc[ai][bj][m][n]; } }
    }
};
struct EpiResBf16 {
    static constexpr bool PERM = true, AFTER_DRAIN = false;
    const float* base; bf16_t* out; int ldc;
    __device__ __forceinline__ void operator()(const f32x4 (&acc)[2][2][4][2], const Unit& u, int wr, int wc, int fr, int fq) const {
        const int row0 = u.pm * BM + wr * 64 + fr, col0 = u.pn * BM + wc * 32 + 8 * fq;
#pragma unroll
        for (int ai = 0; ai < 2; ++ai)
#pragma unroll
            for (int m = 0; m < 4; ++m) { const size_t ro = (size_t)(row0 + ai * HALF + m * 16) * ldc + col0;
#pragma unroll
                for (int bj = 0; bj < 2; ++bj) { const f32x4 b0 = __builtin_nontemporal_load((const f32x4*)(base + ro + bj * HALF)), b1 = __builtin_nontemporal_load((const f32x4*)(base + ro + bj * HALF + 4));
                    const f32x4 v0 = acc[ai][bj][m][0] + b0, v1 = acc[ai][bj][m][1] + b1;
                    u32x4 w; w.x = cvt_pk_bf16(v0[0], v0[1]); w.y = cvt_pk_bf16(v0[2], v0[3]); w.z = cvt_pk_bf16(v1[0], v1[1]); w.w = cvt_pk_bf16(v1[2], v1[3]);
                    *(u32x4*)(out + ro + bj * HALF) = w; } }
    }
};
struct EpiSwiglu {
    static constexpr bool PERM = true, AFTER_DRAIN = false;
    bf16_t* O; int ldo; const float* bg; const float* bu;
    __device__ __forceinline__ void operator()(const f32x4 (&acc)[2][2][4][2], const Unit& u, int wr, int wc, int fr, int fq) const {
        const int e = u.pn >> 4, j = u.pn & 15, col0 = j * HALF + wc * 32 + 8 * fq, row0 = u.pm * BM + wr * 64 + fr;
        f32x4 g_b[2], u_b[2];
#pragma unroll
        for (int n = 0; n < 2; ++n) { g_b[n] = *(const f32x4*)(bg + (size_t)e * 2048 + col0 + 4 * n); u_b[n] = *(const f32x4*)(bu + (size_t)e * 2048 + col0 + 4 * n); }
#pragma unroll
        for (int ai = 0; ai < 2; ++ai)
#pragma unroll
            for (int m = 0; m < 4; ++m) { float h[8];
#pragma unroll
                for (int n = 0; n < 2; ++n)
#pragma unroll
                    for (int i = 0; i < 4; ++i) { const float g = fminf(acc[ai][0][m][n][i] + g_b[n][i], 7.0f); const float uu = fminf(fmaxf(acc[ai][1][m][n][i] + u_b[n][i], -7.0f), 7.0f);
                        h[n * 4 + i] = g * sigmoidf_(1.702f * g) * (uu + 1.0f); }
                u32x4 w; w.x = cvt_pk_bf16(h[0], h[1]); w.y = cvt_pk_bf16(h[2], h[3]); w.z = cvt_pk_bf16(h[4], h[5]); w.w = cvt_pk_bf16(h[6], h[7]);
                *(u32x4*)(O + (size_t)(row0 + ai * HALF + m * 16) * ldo + col0) = w; }
    }
};
__device__ __forceinline__ float sat8(float v) { return __builtin_amdgcn_fmed3f(v, -448.0f, 448.0f); }
__device__ __forceinline__ unsigned pk4_fp8(float a, float b, float c, float d) { int w = 0; w = __builtin_amdgcn_cvt_pk_fp8_f32(a, b, w, false); w = __builtin_amdgcn_cvt_pk_fp8_f32(c, d, w, true); return (unsigned)w; }
struct EpiSwiglu8 {
    static constexpr bool PERM = true, AFTER_DRAIN = false;
    unsigned char* O; int ldo; const float* bg; const float* bu;
    __device__ __forceinline__ void operator()(const f32x4 (&acc)[2][2][4][2], const Unit& u, int wr, int wc, int fr, int fq) const {
        const int e = u.pn >> 4, j = u.pn & 15, col0 = j * HALF + wc * 32 + 8 * fq, row0 = u.pm * BM + wr * 64 + fr;
        f32x4 g_b[2], u_b[2];
#pragma unroll
        for (int n = 0; n < 2; ++n) { g_b[n] = *(const f32x4*)(bg + (size_t)e * 2048 + col0 + 4 * n); u_b[n] = *(const f32x4*)(bu + (size_t)e * 2048 + col0 + 4 * n); }
#pragma unroll
        for (int ai = 0; ai < 2; ++ai)
#pragma unroll
            for (int m = 0; m < 4; ++m) { float h[8];
#pragma unroll
                for (int n = 0; n < 2; ++n)
#pragma unroll
                    for (int i = 0; i < 4; ++i) { const float g = fminf(acc[ai][0][m][n][i] + g_b[n][i], 7.0f); const float uu = fminf(fmaxf(acc[ai][1][m][n][i] + u_b[n][i], -7.0f), 7.0f);
                        h[n * 4 + i] = g * sigmoidf_(1.702f * g) * (uu + 1.0f); }
                typedef unsigned u32x2_t __attribute__((ext_vector_type(2)));
                u32x2_t w; w.x = pk4_fp8(h[0], h[1], h[2], h[3]); w.y = pk4_fp8(h[4], h[5], h[6], h[7]);
                *(u32x2_t*)(O + (size_t)(row0 + ai * HALF + m * 16) * ldo + col0) = w; }
    }
};
struct EpiFp8 {
    static constexpr bool PERM = true, AFTER_DRAIN = false;
    unsigned char* O; int ldc; const float* bias; int ncols;
    __device__ __forceinline__ void operator()(const f32x4 (&acc)[2][2][4][2], const Unit& u, int wr, int wc, int fr, int fq) const {
        const int row0 = u.pm * BM + wr * 64 + fr, bcol0 = u.pn * BM + wc * 32 + 8 * fq, col0 = bcol0 % ncols;
        f32x4 bv[2][2];
#pragma unroll
        for (int bj = 0; bj < 2; ++bj)
#pragma unroll
            for (int n = 0; n < 2; ++n) bv[bj][n] = *(const f32x4*)(bias + bcol0 + bj * HALF + 4 * n);
        typedef unsigned u32x2_t __attribute__((ext_vector_type(2)));
#pragma unroll
        for (int ai = 0; ai < 2; ++ai)
#pragma unroll
            for (int m = 0; m < 4; ++m) { unsigned char* rowp = O + (size_t)(row0 + ai * HALF + m * 16) * ldc + col0;
#pragma unroll
                for (int bj = 0; bj < 2; ++bj) { const f32x4 v0 = acc[ai][bj][m][0] + bv[bj][0], v1 = acc[ai][bj][m][1] + bv[bj][1];
                    u32x2_t w; w.x = pk4_fp8(sat8(v0[0]), sat8(v0[1]), sat8(v0[2]), sat8(v0[3])); w.y = pk4_fp8(sat8(v1[0]), sat8(v1[1]), sat8(v1[2]), sat8(v1[3]));
                    *(u32x2_t*)(rowp + bj * HALF) = w; } }
    }
};
struct MoeOrder {
    const PG8_LAS int* tb; int NT, G, c;
    __device__ __forceinline__ bool next(int i, Unit& u) const {
        const int x = c & 7, k = c >> 3, G8 = G >> 3, NL = NT >> 3;
        const long L = (long)i * G8 + k; const int total = tb[32] * NL; if (L >= (long)total) return false;
        int e = 0;
#pragma unroll 8
        for (int q = 1; q <= 32; ++q) e += (L >= (long)tb[q] * NL) ? 1 : 0;
        e = e > 31 ? 31 : e;
        const int t0 = tb[e], ne = tb[e + 1] - t0, r = (int)(L - (long)t0 * NL), nn = ne > 0 ? ne : 1;
        u.pn = __builtin_amdgcn_readfirstlane(e * NT + x * NL + r / nn); u.pm = __builtin_amdgcn_readfirstlane(t0 + r % nn); return true;
    }
    __device__ __forceinline__ void a_ready(const Unit&) const {}
    __device__ __forceinline__ void done(const Unit&) const {}
};
}
namespace att {
using bf16 = __hip_bfloat16;
constexpr int   D = 128, NW = 8, QBLK = 32, KVBLK = 64;
constexpr float SCALE = 0.088388347648318440f;
constexpr float THR = 0.f;
constexpr int LDQ = 1024, LDK = 1024, LDO = 1024;
constexpr size_t SHM_V = KVBLK * D * 2, SHM_K = KVBLK * D * 2, SHM_ATTN = 2 * SHM_V + 2 * SHM_K + NW * 64 * 4 + 1040;
using bf16x8 = __attribute__((ext_vector_type(8))) short;
using s16x4  = __attribute__((ext_vector_type(4))) short;
using f32x16 = __attribute__((ext_vector_type(16))) float;
using f32x8  = __attribute__((ext_vector_type(8))) float;
using u32x4  = __attribute__((ext_vector_type(4))) unsigned;
#define KSWZ(row, colB) ((row) * 256 + ((colB) ^ (((row) & 7) << 4)))
#define SBAR() __builtin_amdgcn_sched_barrier(0)
__device__ __forceinline__ int crow(int r, int hi) { return (r & 3) + 8 * (r >> 2) + 4 * hi; }
__device__ __forceinline__ unsigned cvtpk(float lo, float hi) {
  unsigned r; asm volatile("v_cvt_pk_bf16_f32 %0, %1, %2" : "=v"(r) : "v"(lo), "v"(hi)); return r;
}
template <typename TIn> struct Stage;
template <> struct Stage<bf16>  { using T = bf16x8;
  __device__ static __forceinline__ T ld8(const bf16* p) { return *reinterpret_cast<const bf16x8*>(p); }
  __device__ static __forceinline__ bf16x8 tobf(T x) { return x; } };
template <> struct Stage<float> { using T = f32x8;
  __device__ static __forceinline__ T ld8(const float* p) { return *reinterpret_cast<const f32x8*>(p); }
  __device__ static __forceinline__ bf16x8 tobf(T x) {
    u32x4 w = {cvtpk(x[0], x[1]), cvtpk(x[2], x[3]), cvtpk(x[4], x[5]), cvtpk(x[6], x[7])}; return *reinterpret_cast<bf16x8*>(&w); } };

__device__ __forceinline__ void partialSM(f32x16& p0, f32x16& p1, float& m_reg, float& mn, float& alpha) {
  constexpr float C = SCALE * 1.4426950408889634f;
  float pmax = p0[0]; for (int r = 1; r < 16; ++r) pmax = fmaxf(pmax, p0[r]); for (int r = 0; r < 16; ++r) pmax = fmaxf(pmax, p1[r]);
  { auto rr = __builtin_amdgcn_permlane32_swap(__float_as_uint(pmax), __float_as_uint(pmax), false, false);
    pmax = fmaxf(__uint_as_float(rr[0]), __uint_as_float(rr[1])); }
  if (__builtin_expect(__all(pmax - m_reg <= THR / SCALE), 1)) { mn = m_reg; alpha = 1.f; }
  else { mn = fmaxf(m_reg, pmax); alpha = __builtin_amdgcn_exp2f((m_reg - mn) * C); m_reg = mn; }
  float mnC = -mn * C;
  for (int r = 0; r < 16; ++r) p0[r] = fmaf(p0[r], C, mnC); for (int r = 0; r < 16; ++r) p1[r] = fmaf(p1[r], C, mnC);
  for (int r = 0; r < 16; ++r) p0[r] = __builtin_amdgcn_exp2f(p0[r]);
}
__device__ __forceinline__ void finishSM(f32x16& p0, f32x16& p1, float alpha, float& l_reg, bf16x8& pa0, bf16x8& pa1, bf16x8& pa2, bf16x8& pa3) {
  for (int r = 0; r < 16; ++r) p1[r] = __builtin_amdgcn_exp2f(p1[r]);
  float ps = 0; for (int r = 0; r < 16; ++r) ps += p0[r]; for (int r = 0; r < 16; ++r) ps += p1[r];
  { auto rr = __builtin_amdgcn_permlane32_swap(__float_as_uint(ps), __float_as_uint(ps), false, false);
    ps = __uint_as_float(rr[0]) + __uint_as_float(rr[1]); }
  l_reg = l_reg * alpha + ps;
#define PK4(P, BASE, OUT) do { unsigned a0 = cvtpk(P[BASE + 0], P[BASE + 1]), a1 = cvtpk(P[BASE + 2], P[BASE + 3]);   \
    unsigned b0 = cvtpk(P[BASE + 4], P[BASE + 5]), b1 = cvtpk(P[BASE + 6], P[BASE + 7]);                              \
    auto r0 = __builtin_amdgcn_permlane32_swap(a0, b0, false, false); auto r1 = __builtin_amdgcn_permlane32_swap(a1, b1, false, false); \
    u32x4 w = {r0[0], r1[0], r0[1], r1[1]}; OUT = *reinterpret_cast<bf16x8*>(&w); } while (0)
  PK4(p0, 0, pa0); PK4(p0, 8, pa1); PK4(p1, 0, pa2); PK4(p1, 8, pa3);
#undef PK4
}
__device__ __forceinline__ void qkt(f32x16& p0, f32x16& p1, const bf16* Ks, const bf16x8* qr, int r32, int hi) {
  p0 = f32x16{}; p1 = f32x16{};
  for (int d0 = 0; d0 < 8; ++d0) { int cb = (d0 * 16 + hi * 8) * 2;
    bf16x8 b0 = *reinterpret_cast<const bf16x8*>((const char*)Ks + KSWZ(r32, cb));
    bf16x8 b1 = *reinterpret_cast<const bf16x8*>((const char*)Ks + KSWZ(32 + r32, cb));
    p0 = __builtin_amdgcn_mfma_f32_32x32x16_bf16(b0, qr[d0], p0, 0, 0, 0);
    p1 = __builtin_amdgcn_mfma_f32_32x32x16_bf16(b1, qr[d0], p1, 0, 0, 0); }
}
__device__ __forceinline__ int v_st(int k, int c) { const int kk = (k & ~0xC) | ((k & 4) << 1) | ((k & 8) >> 1); return ((kk >> 3) * 4 + (c >> 5)) * 512 + ((kk & 7) * 32 + (c & 31)) * 2; }
__device__ __forceinline__ int v_rd_base(int lane) { return ((lane & 3) << 3) | (((lane >> 2) & 3) << 6) | (((lane >> 4) & 1) << 5) | (((lane >> 5) & 1) << 8); }
constexpr int v_rd_off(int d0, int ks, int half) { return d0 * 512 + ks * 4096 + half * 2048; }
template <int OFF> __device__ __forceinline__ s16x4 tr_read(int vb) {
  s16x4 r; asm volatile("ds_read_b64_tr_b16 %0, %1 offset:%2" : "=&v"(r) : "v"(vb), "i"(OFF) : "memory"); return r;
}
template <int D0> __device__ __forceinline__ void pv_one(f32x16& od, int vb, bf16x8 pa0, bf16x8 pa1, bf16x8 pa2, bf16x8 pa3) {
  const s16x4 l0 = tr_read<v_rd_off(D0, 0, 0)>(vb), h0 = tr_read<v_rd_off(D0, 0, 1)>(vb), l1 = tr_read<v_rd_off(D0, 1, 0)>(vb), h1 = tr_read<v_rd_off(D0, 1, 1)>(vb);
  const s16x4 l2 = tr_read<v_rd_off(D0, 2, 0)>(vb), h2 = tr_read<v_rd_off(D0, 2, 1)>(vb), l3 = tr_read<v_rd_off(D0, 3, 0)>(vb), h3 = tr_read<v_rd_off(D0, 3, 1)>(vb);
  asm volatile("s_waitcnt lgkmcnt(0)" ::: "memory"); SBAR();
#define PK(L, H) (bf16x8){L[0], L[1], L[2], L[3], H[0], H[1], H[2], H[3]}
  od = __builtin_amdgcn_mfma_f32_32x32x16_bf16(pa0, PK(l0, h0), od, 0, 0, 0);
  od = __builtin_amdgcn_mfma_f32_32x32x16_bf16(pa1, PK(l1, h1), od, 0, 0, 0);
  od = __builtin_amdgcn_mfma_f32_32x32x16_bf16(pa2, PK(l2, h2), od, 0, 0, 0);
  od = __builtin_amdgcn_mfma_f32_32x32x16_bf16(pa3, PK(l3, h3), od, 0, 0, 0);
#undef PK
}
__device__ __forceinline__ void pv_d0(f32x16* o, int vb, bf16x8 pa0, bf16x8 pa1, bf16x8 pa2, bf16x8 pa3) {
  pv_one<0>(o[0], vb, pa0, pa1, pa2, pa3); pv_one<1>(o[1], vb, pa0, pa1, pa2, pa3); pv_one<2>(o[2], vb, pa0, pa1, pa2, pa3); pv_one<3>(o[3], vb, pa0, pa1, pa2, pa3);
}

__device__ __forceinline__ void bias_mask(f32x16& p0, f32x16& p1, int t, bool valid, int qi, int hi, const float* bt) {
  if (!valid) {
#pragma unroll
    for (int r = 0; r < 16; ++r) { p0[r] = -INFINITY; p1[r] = -INFINITY; }
  } else if (t <= 5) {
    const float c = bt[256];
#pragma unroll
    for (int r = 0; r < 16; ++r) { p0[r] += c; p1[r] += c; }
  } else {
    const int base = 512 + qi - 64 * t;
#pragma unroll
    for (int r = 0; r < 16; ++r) { const int kt = crow(r, hi);
      int r0 = base - kt; r0 = r0 < -128 ? -128 : (r0 > 128 ? 128 : r0);
      int r1 = base - kt - 32; r1 = r1 < -128 ? -128 : (r1 > 128 ? 128 : r1);
      p0[r] += bt[r0 + 128]; p1[r] += bt[r1 + 128]; }
  }
}
__device__ __forceinline__ void attn_unit(int b, int h, int qb, const bf16* __restrict__ Q, const bf16* __restrict__ K, const bf16* __restrict__ V, bf16* __restrict__ O,
                                          const float* __restrict__ rel_bias, char* lds) {
  using St = Stage<bf16>;
  const int tid = threadIdx.x, wid = __builtin_amdgcn_readfirstlane(tid >> 6), lane = tid & 63, r32 = lane & 31, hi = lane >> 5;
  bf16* V_lds = (bf16*)lds; bf16* K_lds = (bf16*)(lds + 2 * SHM_V);
  float* ws = (float*)(lds + 2 * SHM_V + 2 * SHM_K) + wid * 64; float* li_l = ws; float* al_l = ws + 32;
  float* bt = (float*)(lds + 2 * SHM_V + 2 * SHM_K + NW * 64 * 4);
  for (int i = tid; i < 257; i += 64 * NW) bt[i] = rel_bias[h * 257 + i] * (1.0f / SCALE);
  const long rowb = (long)b * 2048;
  const bf16* Qb = Q + (rowb + qb * 256) * LDQ + h * D;
  const bf16* Kh = K + rowb * LDK + h * D; const bf16* Vh = V + rowb * LDK + h * D;
  bf16* Ob = O + (rowb + qb * 256) * LDO + h * D;
  const int cbase = qb * 4 - 8;
  const int ci = wid >> 1, qi = (wid & 1) * 32 + r32;
  float m_reg = -1e30f, l_reg = 0; f32x16 o[4] = {}; bf16x8 qr[8];
  const bf16* Qw = Qb + (long)(wid * QBLK + r32) * LDQ + hi * 8;
#pragma unroll
  for (int d0 = 0; d0 < 8; ++d0) qr[d0] = St::tobf(St::ld8(Qw + d0 * 16));
  const int sr = tid >> 4, sc = (tid & 15) * 8, vst0 = v_st(sr, sc), vst1 = v_st(32 + sr, sc);
  const int vb0 = (int)(uintptr_t)V_lds + v_rd_base(lane);
  struct { typename St::T vs0, vs1, ks0, ks1; } sr_[2];
#define KSTART(j) ((((cbase + (j)) < 0) ? 0 : (cbase + (j))) * 64)
#define TVALID(j) (((j) - ci) >= 0 && ((j) - ci) <= 8 && (cbase + (j)) >= 0)
#define SLOAD(i, k0) do { sr_[i].vs0 = St::ld8(&Vh[(long)((k0) + sr) * LDK + sc]); sr_[i].vs1 = St::ld8(&Vh[(long)((k0) + 32 + sr) * LDK + sc]); \
    sr_[i].ks0 = St::ld8(&Kh[(long)((k0) + sr) * LDK + sc]); sr_[i].ks1 = St::ld8(&Kh[(long)((k0) + 32 + sr) * LDK + sc]); } while (0)
#define SWRITE(bb, i) do { *(bf16x8*)((char*)V_lds + (bb) * SHM_V + vst0) = St::tobf(sr_[i].vs0);          \
    *(bf16x8*)((char*)V_lds + (bb) * SHM_V + vst1) = St::tobf(sr_[i].vs1); int kc = sc * 2;               \
    *(bf16x8*)((char*)K_lds + (bb) * SHM_K + KSWZ(sr, kc)) = St::tobf(sr_[i].ks0);                       \
    *(bf16x8*)((char*)K_lds + (bb) * SHM_K + KSWZ(32 + sr, kc)) = St::tobf(sr_[i].ks1); } while (0)
#define SWAIT() asm volatile("s_waitcnt vmcnt(4)" ::: "memory")
#define RESC(a) do { if (__any((a) < 1.f)) { if (hi == 0) al_l[r32] = (a); asm volatile("s_waitcnt lgkmcnt(0)" ::: "memory"); \
    for (int d = 0; d < 4; ++d) for (int r = 0; r < 16; ++r) o[d][r] *= al_l[crow(r, hi)]; } } while (0)
  f32x16 pA0, pA1, pB0, pB1; float mnA, mnB, alA, alB; bf16x8 pa0, pa1, pa2, pa3; constexpr int NT = 12;
  constexpr int SE = 0, SO = 1;
  SLOAD(SE, KSTART(0)); asm volatile("s_waitcnt vmcnt(0)" ::: "memory"); SWRITE(0, SE); __syncthreads();
  qkt(pA0, pA1, K_lds, qr, r32, hi); bias_mask(pA0, pA1, 0 - ci, TVALID(0), qi, hi, bt); partialSM(pA0, pA1, m_reg, mnA, alA);
  SLOAD(SO, KSTART(1)); SLOAD(SE, KSTART(2));
  SWAIT(); SWRITE(1, SO); __syncthreads();
  for (int j = 1; j + 1 < NT; j += 2) {
    SBAR(); qkt(pB0, pB1, (bf16*)((char*)K_lds + SHM_K), qr, r32, hi);
    finishSM(pA0, pA1, alA, l_reg, pa0, pa1, pa2, pa3); SBAR();
    SLOAD(SO, KSTART(j + 2)); SBAR();
    pv_d0(o, vb0, pa0, pa1, pa2, pa3); bias_mask(pB0, pB1, j - ci, TVALID(j), qi, hi, bt); partialSM(pB0, pB1, m_reg, mnB, alB);
    __syncthreads(); SWAIT(); SWRITE(0, SE);
    RESC(alB); __syncthreads();
    SBAR(); qkt(pA0, pA1, K_lds, qr, r32, hi);
    finishSM(pB0, pB1, alB, l_reg, pa0, pa1, pa2, pa3); SBAR();
    if (j + 3 < NT) SLOAD(SE, KSTART(j + 3)); SBAR();
    pv_d0(o, vb0 + (int)SHM_V, pa0, pa1, pa2, pa3); bias_mask(pA0, pA1, j + 1 - ci, TVALID(j + 1), qi, hi, bt); partialSM(pA0, pA1, m_reg, mnA, alA);
    __syncthreads(); SWAIT(); SWRITE(1, SO);
    RESC(alA); __syncthreads();
  }
  SBAR(); qkt(pB0, pB1, (bf16*)((char*)K_lds + SHM_K), qr, r32, hi);
  finishSM(pA0, pA1, alA, l_reg, pa0, pa1, pa2, pa3); SBAR();
  pv_d0(o, vb0, pa0, pa1, pa2, pa3); bias_mask(pB0, pB1, NT - 1 - ci, TVALID(NT - 1), qi, hi, bt); partialSM(pB0, pB1, m_reg, mnB, alB);
  __syncthreads(); RESC(alB);
  finishSM(pB0, pB1, alB, l_reg, pa0, pa1, pa2, pa3); SBAR();
  pv_d0(o, vb0 + (int)SHM_V, pa0, pa1, pa2, pa3);
  if (hi == 0) li_l[r32] = l_reg; asm volatile("s_waitcnt lgkmcnt(0)" ::: "memory");
  float rli[16];
#pragma unroll
  for (int r = 0; r < 16; ++r) rli[r] = __builtin_amdgcn_rcpf(li_l[crow(r, hi)]);
  bf16* Ow = Ob + (long)(wid * QBLK) * LDO;
#pragma unroll
  for (int r = 0; r < 16; ++r) { const int orow = crow(r, hi);
#pragma unroll
    for (int d0 = 0; d0 < 4; ++d0) Ow[(long)orow * LDO + d0 * 32 + r32] = __float2bfloat16(o[d0][r] * rli[r]); }
  __syncthreads();
#undef KSTART
#undef TVALID
#undef SLOAD
#undef SWRITE
#undef SWAIT
#undef RESC
}
}
#define GAS __attribute__((address_space(1)))
#define LAS __attribute__((address_space(3)))
#define XB_TMO      128
#define XB_XCNT(j)  (256  + 64 * (j))
#define XB_XSUB(j)  (1280 + 64 * (j))
#define XB_XGEN(j)  (2304 + 64 * (j))
#define XB_TOP      3328
#define XB_TOPGEN   3392
#define XCD_BAR_WORDS 3456
#define XB_SPIN_CAP (1u << 18)

__device__ __forceinline__ unsigned xb_ld(unsigned* p)              { return __hip_atomic_load(p, __ATOMIC_RELAXED, __HIP_MEMORY_SCOPE_AGENT); }
__device__ __forceinline__ unsigned xb_add(unsigned* p, unsigned v) { return __hip_atomic_fetch_add(p, v, __ATOMIC_RELAXED, __HIP_MEMORY_SCOPE_AGENT); }
__device__ __forceinline__ unsigned xb_xcc_id() { return (unsigned)__builtin_amdgcn_s_getreg((3 << 11) | 20) & 0xFu; }
#define XB_SPIN(cond, bar) do { unsigned _sp = 0; while (cond) { __builtin_amdgcn_s_sleep(1); \
    if ((++_sp & 255u) == 0u) { if (xb_ld(&(bar)[XB_TMO])) break; if (_sp > XB_SPIN_CAP) { atomicAdd(&(bar)[XB_TMO], 1u); break; } } } } while (0)

struct XcdBarrier {
    unsigned* bar; unsigned x;
    volatile LAS unsigned* st;
};

__device__ __forceinline__ XcdBarrier xcd_barrier_post(unsigned* bar, volatile LAS unsigned* st) {
    XcdBarrier b; b.bar = bar; b.x = xb_xcc_id(); b.st = st;
    if (threadIdx.x == 0) (void)xb_add(&bar[XB_XCNT(b.x)], 1u);
    return b;
}
__device__ __forceinline__ void xcd_barrier_complete(unsigned* bar, unsigned x, unsigned& nloc, unsigned& nx) {
    const unsigned G = gridDim.x * gridDim.y * gridDim.z;
    unsigned sum, cnt, mine, sp = 0u;
    for (;;) {
        sum = 0u; cnt = 0u; mine = 0u;
#pragma unroll
        for (unsigned j = 0; j < 16; ++j) { const unsigned c = xb_ld(&bar[XB_XCNT(j)]); sum += c; cnt += (c > 0u) ? 1u : 0u; mine = (j == x) ? c : mine; }
        if (sum == G) break;
        __builtin_amdgcn_s_sleep(1);
        if ((++sp & 255u) == 0u) { if (xb_ld(&bar[XB_TMO])) break; if (sp > XB_SPIN_CAP) { atomicAdd(&bar[XB_TMO], 1u); break; } }
    }
    nloc = mine > 0u ? mine : 1u; nx = cnt > 0u ? cnt : 1u;
}

__device__ __forceinline__ void xcd_barrier(const XcdBarrier& b) {
    asm volatile("s_waitcnt vmcnt(0)" ::: "memory");
    __syncthreads();
    if (threadIdx.x == 0) {
        unsigned* bar = b.bar;
        __builtin_amdgcn_s_waitcnt(0);
        unsigned nloc = b.st[0], nx = b.st[1];
        if (nloc == 0u) { xcd_barrier_complete(bar, b.x, nloc, nx); b.st[0] = nloc; b.st[1] = nx; }
        const unsigned old = xb_add(&bar[XB_XSUB(b.x)], 1u);
        const unsigned gen = old / nloc;
        if (old + 1u == (gen + 1u) * nloc) {
            __builtin_amdgcn_fence(__ATOMIC_RELEASE, "agent");
            asm volatile("s_waitcnt vmcnt(0)" ::: "memory");
            const unsigned og = xb_add(&bar[XB_TOP], 1u);
            const unsigned tg = og / nx;
            if (og + 1u == (tg + 1u) * nx) xb_add(&bar[XB_TOPGEN], 1u);
            else XB_SPIN(xb_ld(&bar[XB_TOPGEN]) == tg, bar);
            __builtin_amdgcn_fence(__ATOMIC_ACQUIRE, "agent");
            xb_add(&bar[XB_XGEN(b.x)], 1u);
            asm volatile("s_waitcnt vmcnt(0)" ::: "memory");
        } else {
            XB_SPIN(xb_ld(&bar[XB_XGEN(b.x)]) == gen, bar);
            __builtin_amdgcn_fence(__ATOMIC_ACQUIRE, "agent");
            asm volatile("s_waitcnt vmcnt(0)" ::: "memory");
        }
    }
    __syncthreads();
}
constexpr int NWAVES = 8;
constexpr int NB = 8, SEQ = 2048, DM = 2048, T = NB * SEQ;
constexpr int AW = 1024, NH = 8, HD = 128, SW = 1024, NG = 64, GC = 16, NP = 64, INW = 4096;
constexpr int NE = 32, DFF = 2048, NREL = 257;
constexpr float EPS = 1e-5f;
#ifndef MK_N_LAUNCHES
#define MK_N_LAUNCHES 1
#endif
constexpr int NPH = 11;
constexpr int N_LAUNCHES = MK_N_LAUNCHES;

constexpr size_t MiB = 1u << 20;
constexpr size_t WS_CTL = 0, CTL_ZERO_BYTES = 1 * MiB;
constexpr size_t WS_ABAR = 1 * MiB;
constexpr size_t WS_TB = 1 * MiB + 64 * 1024;
constexpr size_t WS_TC = 1 * MiB + 64 * 1024 + 256 * 1024;
constexpr size_t WS_LIST = 2 * MiB;
constexpr size_t WS_TOKE = 4 * MiB, WS_TOKP = 4 * MiB + 256 * 1024, WS_TOKG = 4 * MiB + 512 * 1024;
constexpr size_t WS_WIN = 8 * MiB, WS_WGLU = 24 * MiB, WS_WOUT = 26 * MiB;
constexpr size_t WS_XN = 34 * MiB;
constexpr size_t WS_Q = 98 * MiB, WS_K = 130 * MiB, WS_V = 162 * MiB, WS_U = 194 * MiB;
constexpr size_t WS_AO = 226 * MiB, WS_G = 258 * MiB, WS_S = 290 * MiB;
constexpr size_t WS_MIX = 322 * MiB;
constexpr size_t WS_H1 = 386 * MiB;
constexpr size_t WS_WGU = 514 * MiB;
constexpr size_t WS_XN8 = 770 * MiB;
constexpr size_t WS_WD = 1026 * MiB;
constexpr size_t WS_Y = 1282 * MiB;
constexpr size_t WS_XG = 1570 * MiB;
constexpr size_t WS_HID = 1714 * MiB;
constexpr size_t WS_END = 1858 * MiB;
constexpr int CW_BAR = 4096, CW_CNT = 8192, CW_QUEUE = 12288, CW_P1DONE = 12288 + 128;

constexpr int RING_OFF = 0, RING_BYTES = 139264;
constexpr int MISC_OFF = RING_BYTES;
constexpr int LDS_BYTES = 147456;

typedef unsigned short bf16_t;
typedef unsigned v4u __attribute__((ext_vector_type(4)));
typedef unsigned v2u __attribute__((ext_vector_type(2)));
typedef float f32x4 __attribute__((ext_vector_type(4)));
typedef float f32x2 __attribute__((ext_vector_type(2)));
typedef float f32x16 __attribute__((ext_vector_type(16)));
typedef short bf16x8 __attribute__((ext_vector_type(8)));
#define LDS_WAIT() asm volatile("s_waitcnt lgkmcnt(0)" ::: "memory")
#define VM_WAIT() asm volatile("s_waitcnt vmcnt(0)" ::: "memory")
__device__ __forceinline__ unsigned f2bf(float f) { unsigned u = __builtin_bit_cast(unsigned, f); return (u + 0x7fffu + ((u >> 16) & 1u)) >> 16; }
__device__ __forceinline__ unsigned pk2(float lo, float hi) { return f2bf(lo) | (f2bf(hi) << 16); }
__device__ __forceinline__ float bflo(unsigned w) { return __uint_as_float(w << 16); }
__device__ __forceinline__ float bfhi(unsigned w) { return __uint_as_float(w & 0xffff0000u); }
__device__ __forceinline__ float wave_sum(float v) {
#pragma unroll
    for (int o = 1; o < 64; o <<= 1) v += __shfl_xor(v, o);
    return v;
}
__device__ __forceinline__ float gelu_tanh(float y) {
    const float z = 0.7978845608028654f * (y + 0.044715f * y * y * y);
    const float e = __expf(2.0f * z);
    const float th = 1.0f - 2.0f * __builtin_amdgcn_rcpf(e + 1.0f);
    return 0.5f * y * (1.0f + th);
}

struct Frame {
    LAS unsigned char* lds;
    volatile LAS unsigned* MISC;
    unsigned* ctl;
    int tid, lane, wave, G;
};

struct TrItem { const float* src; bf16_t* dst; int N, K; };
__device__ __forceinline__ bool p0_item_decode(const float* const* in, unsigned char* ws, long it, TrItem& t) {
    if (it < 4096) { const int kb = (int)it / 128, nb = (int)it % 128; t.N = INW; t.K = DM; t.src = in[2] + (size_t)(64 * kb) * INW + 32 * nb; t.dst = (bf16_t*)(ws + WS_WIN) + (size_t)(32 * nb) * DM + 64 * kb; return true; }
    it -= 4096;
    if (it < 512) { const int kb = (int)it / 32, nb = (int)it % 32; t.N = SW; t.K = SW; t.src = in[12] + (size_t)(64 * kb) * SW + 32 * nb; t.dst = (bf16_t*)(ws + WS_WGLU) + (size_t)(32 * nb) * SW + 64 * kb; return true; }
    it -= 512;
    if (it < 2048) { const int kb = (int)it / 64, nb = (int)it % 64; t.N = DM; t.K = DM; t.src = in[16] + (size_t)(64 * kb) * DM + 32 * nb; t.dst = (bf16_t*)(ws + WS_WOUT) + (size_t)(32 * nb) * DM + 64 * kb; return true; }
    it -= 2048;
    if (it < (long)NE * 3 * 2048) {
        const int e = (int)(it / 6144), r = (int)(it % 6144), which = r / 2048, q = r % 2048, kb = q / 64, nb = q % 64, n0 = 32 * nb;
        t.N = 2048; t.K = 2048;
        const float* W = which == 0 ? in[20] : (which == 1 ? in[22] : in[24]);
        t.src = W + (size_t)e * 2048 * 2048 + (size_t)(64 * kb) * 2048 + n0;
        if (which == 2) t.dst = (bf16_t*)(ws + WS_WD) + ((size_t)e * 2048 + n0) * 2048 + 64 * kb;
        else t.dst = (bf16_t*)(ws + WS_WGU) + ((size_t)e * 4096 + (size_t)(n0 >> 7) * 256 + (which == 1 ? 128 : 0) + (n0 & 127)) * 2048 + 64 * kb;
        return true;
    }
    return false;
}
constexpr long P0_NITEMS = 4096 + 512 + 2048 + (long)NE * 3 * 2048;
__device__ __forceinline__ void p0_item_load(const TrItem& t, int lane, f32x4 (&v)[8]) {
    const float* p = t.src + (size_t)(lane >> 3) * t.N + 4 * (lane & 7);
#pragma unroll
    for (int i = 0; i < 8; ++i) v[i] = *(const f32x4*)(p + (size_t)(8 * i) * t.N);
}
__device__ __forceinline__ void p0_item_store(const TrItem& t, int lane, const f32x4 (&v)[8], LAS float* scr) {
    const int kk = lane >> 3, n4 = 4 * (lane & 7);
#pragma unroll
    for (int i = 0; i < 8; ++i) { LAS float* s = scr + (kk + 8 * i) * 33 + n4; s[0] = v[i][0]; s[1] = v[i][1]; s[2] = v[i][2]; s[3] = v[i][3]; }
    LDS_WAIT();
    const int c = lane & 7;
#pragma unroll
    for (int j = 0; j < 4; ++j) { const int n = (lane >> 3) + 8 * j; const LAS float* s = scr + (8 * c) * 33 + n;
        v4u o; o.x = pg8::cvt_pk_bf16(s[0 * 33], s[1 * 33]); o.y = pg8::cvt_pk_bf16(s[2 * 33], s[3 * 33]); o.z = pg8::cvt_pk_bf16(s[4 * 33], s[5 * 33]); o.w = pg8::cvt_pk_bf16(s[6 * 33], s[7 * 33]);
        *(v4u*)(t.dst + (size_t)n * t.K + 8 * c) = o; }
    LDS_WAIT();
}
__device__ __forceinline__ void rms_row_to_bf16(const float* xrow, const float* gain, bf16_t* orow, int lane) {
    f32x4 v[8]; float s = 0.f;
#pragma unroll
    for (int j = 0; j < 8; ++j) { v[j] = *(const f32x4*)(xrow + 4 * (lane + 64 * j)); s += (v[j].x * v[j].x + v[j].y * v[j].y) + (v[j].z * v[j].z + v[j].w * v[j].w); }
    const float r = 1.0f / sqrtf(wave_sum(s) * (1.0f / DM) + EPS);
#pragma unroll
    for (int j = 0; j < 8; ++j) { const f32x4 g = *(const f32x4*)(gain + 4 * (lane + 64 * j));
        v2u o; o.x = pk2(v[j].x * r * g.x, v[j].y * r * g.y); o.y = pk2(v[j].z * r * g.z, v[j].w * r * g.w);
        *(v2u*)(orow + 4 * (lane + 64 * j)) = o; }
}
__device__ __forceinline__ void s5_disc(const float* const* in, int g, int p, double& are, double& aim, double& fre, double& fim) {
    const double dt = exp((double)in[6][g]); const double lr = (double)in[4][g * 64 + p], li = (double)in[5][g * 64 + p];
    const double mag = exp(lr * dt); are = mag * cos(li * dt); aim = mag * sin(li * dt);
    const double den = lr * lr + li * li, nr = are - 1.0, ni = aim;
    fre = (nr * lr + ni * li) / den; fim = (ni * lr - nr * li) / den;
}
__device__ __forceinline__ void conv_items(const float* const* in, unsigned char* ws, long it0, long step, int n, LAS float* scr, int lane) {
    if (n <= 0) return;
    TrItem t0, t1, t2, t3; f32x4 v0[8], v1[8], v2[8], v3[8];
#define CV_LOAD(T_, V_, idx) do { if ((idx) < n) { p0_item_decode(in, ws, it0 + (long)(idx) * step, T_); p0_item_load(T_, lane, V_); } } while (0)
#define CV_STORE(T_, V_, idx) do { if ((idx) < n) p0_item_store(T_, lane, V_, scr); } while (0)
    CV_LOAD(t0, v0, 0); CV_LOAD(t1, v1, 1); CV_LOAD(t2, v2, 2);
    for (int i = 0; i < n; i += 4) {
        CV_LOAD(t3, v3, i + 3); CV_STORE(t0, v0, i);
        CV_LOAD(t0, v0, i + 4); CV_STORE(t1, v1, i + 1);
        CV_LOAD(t1, v1, i + 5); CV_STORE(t2, v2, i + 2);
        CV_LOAD(t2, v2, i + 6); CV_STORE(t3, v3, i + 3);
    }
#undef CV_LOAD
#undef CV_STORE
}
constexpr int P0_SMALL_ITEMS = 4096 + 512 + 2048;
struct TrItem8 { const float* src; unsigned char* dst; };
__device__ __forceinline__ void p8_item_decode(const float* const* in, unsigned char* ws, int it, TrItem8& t) {
    const int e = it / 3072, r = it % 3072, which = r >> 10, q = r & 1023, kb = q >> 6, nb = q & 63, n0 = 32 * nb, k0 = 128 * kb;
    const float* W = which == 0 ? in[20] : (which == 1 ? in[22] : in[24]);
    t.src = W + (size_t)e * 2048 * 2048 + (size_t)k0 * 2048 + n0;
    if (which == 2) t.dst = ws + WS_WD + ((size_t)e * 2048 + n0) * 2048 + k0;
    else t.dst = ws + WS_WGU + ((size_t)e * 4096 + (size_t)(n0 >> 7) * 256 + (which == 1 ? 128 : 0) + (n0 & 127)) * 2048 + k0;
}
__device__ __forceinline__ void p8_item_load(const TrItem8& t, int lane, f32x4 (&v)[16]) {
    const float* p = t.src + (size_t)(4 * (lane >> 3)) * 2048 + 4 * (lane & 7);
#pragma unroll
    for (int i = 0; i < 4; ++i)
#pragma unroll
        for (int kq = 0; kq < 4; ++kq) v[4 * i + kq] = __builtin_nontemporal_load((const f32x4*)(p + (size_t)(32 * i + kq) * 2048));
}
__device__ __forceinline__ void p8_item_store(const TrItem8& t, int lane, const f32x4 (&v)[16], LAS unsigned* scr) {
    const int kb4 = lane >> 3, n4 = 4 * (lane & 7);
#pragma unroll
    for (int i = 0; i < 4; ++i)
#pragma unroll
        for (int q = 0; q < 4; ++q)
            scr[(n4 + q) * 33 + kb4 + 8 * i] = pg8::pk4_fp8(v[4 * i][q] * 32.0f, v[4 * i + 1][q] * 32.0f, v[4 * i + 2][q] * 32.0f, v[4 * i + 3][q] * 32.0f);
    LDS_WAIT();
    const int c = lane & 7;
#pragma unroll
    for (int j = 0; j < 4; ++j) { const int n = (lane >> 3) + 8 * j; const LAS unsigned* s = scr + n * 33 + 4 * c;
        v4u o; o.x = s[0]; o.y = s[1]; o.z = s[2]; o.w = s[3];
        __builtin_nontemporal_store(o, (v4u*)(t.dst + (size_t)n * 2048 + 16 * c)); }
    LDS_WAIT();
}
constexpr int CONV_UNIT_ITEMS = 64, N_CONV_UNITS = NE * 3 * 1024 / CONV_UNIT_ITEMS;
constexpr int CONV8_WAVE_BYTES = 32 * 33 * 4;
__device__ __forceinline__ void conv_unit8(const float* const* in, unsigned char* ws, int cu, int wave, int lane, LAS unsigned* scr) {
    TrItem8 ta, tb_; f32x4 va[16], vb[16];
    const int it0 = cu * CONV_UNIT_ITEMS + wave;
    p8_item_decode(in, ws, it0, ta); p8_item_load(ta, lane, va);
#pragma unroll 1
    for (int i = 0; i < CONV_UNIT_ITEMS / NWAVES; i += 2) {
        p8_item_decode(in, ws, it0 + 8 * (i + 1), tb_); p8_item_load(tb_, lane, vb);
        p8_item_store(ta, lane, va, scr);
        if (i + 2 < CONV_UNIT_ITEMS / NWAVES) { p8_item_decode(in, ws, it0 + 8 * (i + 2), ta); p8_item_load(ta, lane, va); }
        p8_item_store(tb_, lane, vb, scr);
    }
}
__device__ __forceinline__ void conv_unit8_deep(const float* const* in, unsigned char* ws, int cu, int wave, int lane, LAS unsigned* scr) {
    TrItem8 ta, tb_, tc; f32x4 va[16], vb[16], vc[16];
    constexpr int NI = CONV_UNIT_ITEMS / NWAVES;
    const int it0 = cu * CONV_UNIT_ITEMS + wave;
#define C8_LOAD(T_, V_, idx) do { if ((idx) < NI) { p8_item_decode(in, ws, it0 + 8 * (idx), T_); p8_item_load(T_, lane, V_); } } while (0)
#define C8_STORE(T_, V_, idx) do { if ((idx) < NI) p8_item_store(T_, lane, V_, scr); } while (0)
    C8_LOAD(ta, va, 0); C8_LOAD(tb_, vb, 1);
#pragma unroll 1
    for (int i = 0; i < NI; i += 3) {
        C8_LOAD(tc, vc, i + 2); C8_STORE(ta, va, i);
        C8_LOAD(ta, va, i + 3); C8_STORE(tb_, vb, i + 1);
        C8_LOAD(tb_, vb, i + 4); C8_STORE(tc, vc, i + 2);
    }
#undef C8_LOAD
#undef C8_STORE
}
__device__ __forceinline__ void p0_prologue(Frame& F, const float* const* in, unsigned char* ws) {
    LAS float* scr = (LAS float*)(F.lds + RING_OFF + F.wave * 16384);
    const int gw = (int)blockIdx.x * NWAVES + F.wave, NGW = F.G * NWAVES;
    { const int n = gw < P0_SMALL_ITEMS ? (P0_SMALL_ITEMS - gw + NGW - 1) / NGW : 0; conv_items(in, ws, gw, NGW, n, scr, F.lane); }
    for (int m = gw; m < T; m += NGW) rms_row_to_bf16(in[0] + (size_t)m * DM, in[1], (bf16_t*)(ws + WS_XN) + (size_t)m * DM, F.lane);
    for (int it = gw; it < 64 + 256 + 256; it += NGW) {
        if (it < 64) { const int g = it, p = F.lane; double are, aim, fre, fim; s5_disc(in, g, p, are, aim, fre, fim);
            float* ab = (float*)(ws + WS_ABAR) + (g * 64 + p) * 2; ab[0] = (float)are; ab[1] = (float)aim; }
        else if (it < 320) { const int g = (it - 64) >> 2, cb = (it - 64) & 3, col = 32 * cb + (F.lane & 31), hi = F.lane >> 5, p = col & 63; const bool im = col >= 64;
            double are, aim, fre, fim; s5_disc(in, g, p, are, aim, fre, fim);
            unsigned w[4];
#pragma unroll
            for (int j2 = 0; j2 < 4; ++j2) { float o[2];
#pragma unroll
                for (int q = 0; q < 2; ++q) { const int c = 8 * hi + 2 * j2 + q; const double br = (double)in[7][(g * 64 + p) * 16 + c], bi = (double)in[8][(g * 64 + p) * 16 + c];
                    o[q] = (float)(im ? (fre * bi + fim * br) : (fre * br - fim * bi)); }
                w[j2] = pk2(o[0], o[1]); }
            *(v4u*)((bf16_t*)(ws + WS_TB) + ((size_t)(g * 4 + cb) * 64 + F.lane) * 8) = (v4u){w[0], w[1], w[2], w[3]}; }
        else { const int g = (it - 320) >> 2, kk = (it - 320) & 3, c = F.lane & 15, kq = F.lane >> 4;
            unsigned w[4];
#pragma unroll
            for (int j2 = 0; j2 < 4; ++j2) { float o[2];
#pragma unroll
                for (int q = 0; q < 2; ++q) { const int k = 32 * kk + 8 * kq + 2 * j2 + q;
                    o[q] = k < 64 ? in[9][(g * 16 + c) * 64 + k] : -in[10][(g * 16 + c) * 64 + (k - 64)]; }
                w[j2] = pk2(o[0], o[1]); }
            *(v4u*)((bf16_t*)(ws + WS_TC) + ((size_t)(g * 4 + kk) * 64 + F.lane) * 8) = (v4u){w[0], w[1], w[2], w[3]}; }
    }
}

constexpr int S5_ROWF = 132, S5_WAVE_BYTES = 32 * S5_ROWF * 4;
static_assert(NWAVES * S5_WAVE_BYTES <= RING_BYTES, "S5 scratch");
__device__ __forceinline__ void s5_sequence(int s, const bf16_t* U, bf16_t* Gout, const float* ABAR, const bf16_t* TB, const bf16_t* TC, const float* dvec, LAS unsigned char* ldsw, int lane) {
    const int b = s >> 6, g = s & 63, r32 = lane & 31, hi = lane >> 5, c16 = lane & 15, fq = lane >> 4;
    const bf16_t* Ub = U + (size_t)b * SEQ * SW + g * GC;
    bf16_t* Gb = Gout + (size_t)b * SEQ * SW + g * GC;
    bf16x8 bfr[4], cfr[4];
#pragma unroll
    for (int i = 0; i < 4; ++i) { bfr[i] = *(const bf16x8*)(TB + ((size_t)(g * 4 + i) * 64 + lane) * 8); cfr[i] = *(const bf16x8*)(TC + ((size_t)(g * 4 + i) * 64 + lane) * 8); }
    const float are = ABAR[(g * 64 + lane) * 2], aim = ABAR[(g * 64 + lane) * 2 + 1], dv = dvec[g * GC + c16];
    float hr = 0.f, hm = 0.f;
    LAS float* X = (LAS float*)ldsw;
    bf16x8 uf = *(const bf16x8*)(Ub + (size_t)r32 * SW + 8 * hi);
    for (int ci = 0; ci < SEQ / 32; ++ci) {
        const int t0 = 32 * ci;
        bf16x8 ufn = uf;
        if (ci + 1 < SEQ / 32) ufn = *(const bf16x8*)(Ub + (size_t)(t0 + 32 + r32) * SW + 8 * hi);
        bf16_t uq[2][4];
#pragma unroll
        for (int rb = 0; rb < 2; ++rb)
#pragma unroll
            for (int j = 0; j < 4; ++j) uq[rb][j] = Ub[(size_t)(t0 + 16 * rb + 4 * fq + j) * SW + c16];
#pragma unroll
        for (int cb = 0; cb < 4; ++cb) {
            f32x16 acc = {};
            acc = __builtin_amdgcn_mfma_f32_32x32x16_bf16(uf, bfr[cb], acc, 0, 0, 0);
#pragma unroll
            for (int r = 0; r < 16; ++r) X[((r & 3) + 8 * (r >> 2) + 4 * hi) * S5_ROWF + 32 * cb + r32] = acc[r];
        }
        LDS_WAIT(); __syncthreads();
#pragma unroll 8
        for (int t = 0; t < 32; ++t) {
            const float xr = X[t * S5_ROWF + lane], xi = X[t * S5_ROWF + 64 + lane];
            const float nr = are * hr - aim * hm + xr, ni = are * hm + aim * hr + xi;
            hr = nr; hm = ni;
            LAS bf16_t* hrow = (LAS bf16_t*)(X + t * S5_ROWF);
            hrow[lane] = (bf16_t)f2bf(hr); hrow[64 + lane] = (bf16_t)f2bf(hm);
        }
        LDS_WAIT(); __syncthreads();
#pragma unroll
        for (int rb = 0; rb < 2; ++rb) {
            f32x4 a4 = {0.f, 0.f, 0.f, 0.f};
#pragma unroll
            for (int kk = 0; kk < 4; ++kk) {
                const bf16x8 af = *(const LAS bf16x8*)((LAS unsigned char*)ldsw + (16 * rb + c16) * (S5_ROWF * 4) + (32 * kk + 8 * fq) * 2);
                a4 = __builtin_amdgcn_mfma_f32_16x16x32_bf16(af, cfr[kk], a4, 0, 0, 0);
            }
#pragma unroll
            for (int j = 0; j < 4; ++j) { const int t = t0 + 16 * rb + 4 * fq + j;
                const float uval = __uint_as_float((unsigned)uq[rb][j] << 16);
                const float y = a4[j] + dv * uval;
                Gb[(size_t)t * SW + c16] = (bf16_t)f2bf(gelu_tanh(y)); }
        }
        LDS_WAIT(); __syncthreads();
        uf = ufn;
    }
}

__device__ __forceinline__ void moe_tables(Frame& F) {
    __syncthreads();
    if (F.wave == 0) {
        unsigned c = 0;
        if (F.lane < NE) c = __hip_atomic_load(F.ctl + CW_CNT + 64 * F.lane, __ATOMIC_RELAXED, __HIP_MEMORY_SCOPE_AGENT);
        c = c > (unsigned)T ? (unsigned)T : c;
        int nt = (int)((c + 255u) >> 8), incl = nt;
#pragma unroll
        for (int o = 1; o < 32; o <<= 1) { const int v = __shfl_up(incl, o); if (F.lane >= o) incl += v; }
        if (F.lane < NE) F.MISC[25 + F.lane] = (unsigned)incl;
        if (F.lane == 0) F.MISC[24] = 0u;
    }
    __syncthreads();
}
struct Args { const float* in[27]; float* out; unsigned char* ws; int ph_lo, ph_hi, li, pad; };
__global__ void __launch_bounds__(NWAVES * 64, 2) mk_fwd(Args args) {
    extern __shared__ __attribute__((aligned(16))) unsigned char lds[];
    Frame F;
    F.lds = (LAS unsigned char*)lds;
    F.MISC = (volatile LAS unsigned*)(F.lds + MISC_OFF);
    F.tid = threadIdx.x; F.lane = F.tid & 63; F.wave = __builtin_amdgcn_readfirstlane(F.tid >> 6);
    F.G = gridDim.x;
    unsigned char* ws = args.ws;
    F.ctl = (unsigned*)(ws + WS_CTL);
    const float* const* in = args.in;
    for (int u = F.tid; u < (LDS_BYTES - MISC_OFF) / 4; u += NWAVES * 64) ((LAS unsigned*)(F.lds + MISC_OFF))[u] = 0u;
    __syncthreads();
    XcdBarrier bar; bar.bar = F.ctl + CW_BAR; bar.x = 0; bar.st = nullptr;
    if (N_LAUNCHES == 1) bar = xcd_barrier_post(F.ctl + CW_BAR, F.MISC + 8);
#define GRID_BAR() do { if (N_LAUNCHES == 1) xcd_barrier(bar); } while (0)
    const int lo = args.ph_lo, hi = args.ph_hi;
#define IN(k) (lo <= (k) && (k) < hi)
    const int gw = (int)blockIdx.x * NWAVES + F.wave, NGW = F.G * NWAVES;
    bf16_t* const XN = (bf16_t*)(ws + WS_XN);
    bf16_t* const Qb = (bf16_t*)(ws + WS_Q); bf16_t* const Kb = (bf16_t*)(ws + WS_K); bf16_t* const Vb = (bf16_t*)(ws + WS_V); bf16_t* const Ub = (bf16_t*)(ws + WS_U);
    bf16_t* const AO = (bf16_t*)(ws + WS_AO); bf16_t* const GB = (bf16_t*)(ws + WS_G); bf16_t* const SB = (bf16_t*)(ws + WS_S); bf16_t* const MIX = (bf16_t*)(ws + WS_MIX);
    bf16_t* const H1 = (bf16_t*)(ws + WS_H1);
    bf16_t* const XN2T = (bf16_t*)(ws + WS_XG);
    unsigned char* const HID8 = ws + WS_HID; unsigned char* const XN8 = ws + WS_XN8; unsigned char* const Y8 = ws + WS_Y;
    int* const LIST = (int*)(ws + WS_LIST); int* const TOKE = (int*)(ws + WS_TOKE); int* const TOKP = (int*)(ws + WS_TOKP); float* const TOKG = (float*)(ws + WS_TOKG);
    const LAS int* tb = (const LAS int*)(F.lds + MISC_OFF + 24 * 4);

    if (IN(0)) { p0_prologue(F, in, ws); GRID_BAR(); }

    if (IN(1)) {
#ifndef NCONV_WG_
#define NCONV_WG_ 48
#endif
        constexpr int NCONV_WG = NCONV_WG_;
        const int GG = (NCONV_WG > 0 && F.G > 2 * NCONV_WG) ? F.G - NCONV_WG : F.G;
        if ((int)blockIdx.x < GG) {
            pg8::Gemm g{XN, (const bf16_t*)(ws + WS_WIN), T, INW, DM}; pg8::StaticOrder S; S.init(T, INW, GG, (int)blockIdx.x);
            pg8::EpiBf16<0> E{Qb, AW, nullptr, AW, (size_t)(WS_K - WS_Q) / 2, 1.0f};
            pg8::gemm_phase<pg8::EpiBf16<0>, pg8::StaticOrder, true, true>(F.lds + RING_OFF, g, S, E);
            if (F.tid == 0) __hip_atomic_fetch_add(F.ctl + CW_P1DONE, 1u, __ATOMIC_RELAXED, __HIP_MEMORY_SCOPE_AGENT);
        } else {
            for (;;) {
                if (F.tid == 0) { const unsigned dn = __hip_atomic_load(F.ctl + CW_P1DONE, __ATOMIC_RELAXED, __HIP_MEMORY_SCOPE_AGENT);
                    F.MISC[16] = dn >= (unsigned)GG ? 0xffffffffu : __hip_atomic_fetch_add(F.ctl + CW_QUEUE, 1u, __ATOMIC_RELAXED, __HIP_MEMORY_SCOPE_AGENT); }
                __syncthreads();
                const unsigned cu = F.MISC[16];
                __syncthreads();
                if (cu >= (unsigned)N_CONV_UNITS) break;
                conv_unit8_deep(in, ws, (int)cu, F.wave, F.lane, (LAS unsigned*)(F.lds + RING_OFF + F.wave * CONV8_WAVE_BYTES));
            }
        }
        GRID_BAR();
    }

    if (IN(2)) {
        constexpr int N_S5U = NB * NG / NWAVES, N_ATU = NB * NH * (SEQ / 256);
        if ((int)blockIdx.x < N_S5U)
            s5_sequence((int)blockIdx.x * NWAVES + F.wave, Ub, GB, (const float*)(ws + WS_ABAR), (const bf16_t*)(ws + WS_TB), (const bf16_t*)(ws + WS_TC), in[11],
                        F.lds + RING_OFF + F.wave * S5_WAVE_BYTES, F.lane);
        __syncthreads();
#ifndef P2_ATTN_FIRST_
#define P2_ATTN_FIRST_ 48
#endif
        if ((int)blockIdx.x >= N_S5U && (int)blockIdx.x < F.G - P2_ATTN_FIRST_) {
            for (;;) {
                if (F.tid == 0) F.MISC[16] = __hip_atomic_fetch_add(F.ctl + CW_QUEUE, 1u, __ATOMIC_RELAXED, __HIP_MEMORY_SCOPE_AGENT);
                __syncthreads();
                const int cu = (int)F.MISC[16];
                __syncthreads();
                if (cu >= N_CONV_UNITS) break;
                conv_unit8(in, ws, (int)cu, F.wave, F.lane, (LAS unsigned*)(F.lds + RING_OFF + F.wave * CONV8_WAVE_BYTES));
            }
        }
        for (;;) {
            if (F.tid == 0) F.MISC[16] = __hip_atomic_fetch_add(F.ctl + CW_QUEUE + 64, 1u, __ATOMIC_RELAXED, __HIP_MEMORY_SCOPE_AGENT);
            __syncthreads();
            const int a = (int)F.MISC[16];
            __syncthreads();
            if (a >= N_ATU) break;
            const int qb = a & 7, h = (a >> 3) & 7, b = a >> 6;
            att::attn_unit(b, h, qb, (const att::bf16*)Qb, (const att::bf16*)Kb, (const att::bf16*)Vb, (att::bf16*)AO, in[3], (char*)lds + RING_OFF);
        }
        GRID_BAR();
    }

    if (IN(3)) {
        pg8::Gemm g{GB, (const bf16_t*)(ws + WS_WGLU), T, SW, SW}; pg8::StaticOrder S; S.init(T, SW, F.G, (int)blockIdx.x);
        pg8::EpiGlu E{GB, SB, SW, in[13]};
        pg8::gemm_phase<pg8::EpiGlu, pg8::StaticOrder, true, true>(F.lds + RING_OFF, g, S, E);
        GRID_BAR();
    }

    if (IN(4)) {
        for (int m = gw; m < T; m += NGW) {
#pragma unroll
            for (int half = 0; half < 2; ++half) {
                const bf16_t* src = (half ? SB : AO) + (size_t)m * AW; const float* gain = in[half ? 15 : 14];
                v4u w[2]; float s = 0.f;
#pragma unroll
                for (int j = 0; j < 2; ++j) { w[j] = *(const v4u*)(src + 8 * (F.lane + 64 * j));
#pragma unroll
                    for (int q = 0; q < 4; ++q) { const float a = bflo(w[j][q]), bq = bfhi(w[j][q]); s += a * a + bq * bq; } }
                const float r = 1.0f / sqrtf(wave_sum(s) * (1.0f / AW) + EPS);
#pragma unroll
                for (int j = 0; j < 2; ++j) { const int col = 8 * (F.lane + 64 * j); const f32x4 g0 = *(const f32x4*)(gain + col), g1 = *(const f32x4*)(gain + col + 4);
                    v4u o; o.x = pk2(bflo(w[j].x) * r * g0.x, bfhi(w[j].x) * r * g0.y); o.y = pk2(bflo(w[j].y) * r * g0.z, bfhi(w[j].y) * r * g0.w);
                    o.z = pk2(bflo(w[j].z) * r * g1.x, bfhi(w[j].z) * r * g1.y); o.w = pk2(bflo(w[j].w) * r * g1.z, bfhi(w[j].w) * r * g1.w);
                    *(v4u*)(MIX + (size_t)m * DM + half * AW + col) = o; }
            }
        }
        GRID_BAR();
    }

    if (IN(5)) {
        pg8::Gemm g{MIX, (const bf16_t*)(ws + WS_WOUT), T, DM, DM}; pg8::StaticOrder S; S.init(T, DM, F.G, (int)blockIdx.x);
        pg8::EpiResBf16 E{in[0], H1, DM};
        pg8::gemm_phase<pg8::EpiResBf16, pg8::StaticOrder, true, true>(F.lds + RING_OFF, g, S, E);
        GRID_BAR();
    }

    if (IN(6)) {
        constexpr int N2S = 2052;
        LAS float* n2s = (LAS float*)(F.lds + RING_OFF);
        static_assert(16 * N2S * 4 <= RING_BYTES, "router tile");
        for (int pass = (int)blockIdx.x; pass < T / 16; pass += F.G) {
#pragma unroll 1
            for (int rr = 0; rr < 2; ++rr) {
                const int lr = 2 * F.wave + rr, row = 16 * pass + lr;
                const bf16_t* xrow = H1 + (size_t)row * DM;
                f32x4 v[8]; float s = 0.f;
#pragma unroll
                for (int j = 0; j < 8; ++j) { const v2u w = *(const v2u*)(xrow + 4 * (F.lane + 64 * j)); v[j] = (f32x4){bflo(w.x), bfhi(w.x), bflo(w.y), bfhi(w.y)};
                    s += (v[j].x * v[j].x + v[j].y * v[j].y) + (v[j].z * v[j].z + v[j].w * v[j].w); }
                const float r = 1.0f / sqrtf(wave_sum(s) * (1.0f / DM) + EPS);
#pragma unroll
                for (int j = 0; j < 8; ++j) { const int col = 4 * (F.lane + 64 * j); const f32x4 g = *(const f32x4*)(in[17] + col);
                    const f32x4 n = {v[j].x * r * g.x, v[j].y * r * g.y, v[j].z * r * g.z, v[j].w * r * g.w};
                    *(LAS f32x4*)(n2s + lr * N2S + col) = n;
                    *(unsigned*)(XN8 + (size_t)row * DM + col) = pg8::pk4_fp8(n.x, n.y, n.z, n.w); }
            }
            __syncthreads();
            f32x4 lg0 = {0.f, 0.f, 0.f, 0.f}, lg1 = {0.f, 0.f, 0.f, 0.f};
            {
                const int c16 = F.lane & 15, kq = F.lane >> 4;
                const LAS float* ap = n2s + c16 * N2S + 256 * F.wave + kq;
                const float* bp = in[18] + (size_t)(256 * F.wave + kq) * NE + c16;
#pragma unroll 8
                for (int s4 = 0; s4 < 64; ++s4) {
                    const float av = ap[4 * s4]; const float b0 = bp[(size_t)(4 * s4) * NE], b1 = bp[(size_t)(4 * s4) * NE + 16];
                    lg0 = __builtin_amdgcn_mfma_f32_16x16x4f32(av, b0, lg0, 0, 0, 0);
                    lg1 = __builtin_amdgcn_mfma_f32_16x16x4f32(av, b1, lg1, 0, 0, 0);
                }
            }
            __syncthreads();
            {
                const int c16 = F.lane & 15, tq = F.lane >> 4;
#pragma unroll
                for (int j = 0; j < 4; ++j) { n2s[(F.wave * 16 + 4 * tq + j) * 32 + c16] = lg0[j]; n2s[(F.wave * 16 + 4 * tq + j) * 32 + 16 + c16] = lg1[j]; }
            }
            __syncthreads();
            {
                const int tl = F.tid >> 5, e = F.tid & 31, token = 16 * pass + tl;
                float val = in[19][e];
#pragma unroll
                for (int w = 0; w < NWAVES; ++w) val += n2s[(w * 16 + tl) * 32 + e];
                float tv0 = 0.f, tv1 = 0.f, tv2 = 0.f, tv3 = 0.f; int ti0 = 0, ti1 = 0, ti2 = 0, ti3 = 0;
#pragma unroll
                for (int k = 0; k < 4; ++k) {
                    float bv = val; int bi = e;
#pragma unroll
                    for (int off = 16; off >= 1; off >>= 1) { const float ov = __shfl_xor(bv, off); const int oi = __shfl_xor(bi, off); if (ov > bv || (ov == bv && oi < bi)) { bv = ov; bi = oi; } }
                    if (k == 0) { tv0 = bv; ti0 = bi; } else if (k == 1) { tv1 = bv; ti1 = bi; } else if (k == 2) { tv2 = bv; ti2 = bi; } else { tv3 = bv; ti3 = bi; }
                    if (e == bi) val = -INFINITY;
                }
                const float e0 = 1.0f, e1 = __expf(tv1 - tv0), e2 = __expf(tv2 - tv0), e3 = __expf(tv3 - tv0), inv = 1.0f / (e0 + e1 + e2 + e3);
                if (e < 4) {
                    const int ek = e == 0 ? ti0 : (e == 1 ? ti1 : (e == 2 ? ti2 : ti3));
                    const float gk = (e == 0 ? e0 : (e == 1 ? e1 : (e == 2 ? e2 : e3))) * inv;
                    const unsigned pos = __hip_atomic_fetch_add(F.ctl + CW_CNT + 64 * ek, 1u, __ATOMIC_RELAXED, __HIP_MEMORY_SCOPE_AGENT);
                    if (pos < (unsigned)T) LIST[(size_t)ek * T + pos] = token;
                    TOKE[token * 4 + e] = ek; TOKP[token * 4 + e] = (int)pos; TOKG[token * 4 + e] = gk;
                }
            }
            __syncthreads();
        }
        GRID_BAR();
    }

    if (IN(8)) {
        moe_tables(F);
        pg8::Gemm g{(const bf16_t*)XN8, (const bf16_t*)(ws + WS_WGU), 0, 0, DM / 2, LIST, tb, 4, T}; pg8::MoeOrder S{tb, 16, F.G, (int)blockIdx.x};
        pg8::EpiSwiglu8 E{HID8, DFF, in[21], in[23]};
        pg8::gemm_phase<pg8::EpiSwiglu8, pg8::MoeOrder, true, true, true, true>(F.lds + RING_OFF, g, S, E);
        GRID_BAR();
    }

    if (IN(9)) {
        moe_tables(F);
        pg8::Gemm g{(const bf16_t*)HID8, (const bf16_t*)(ws + WS_WD), 0, 0, DFF / 2}; pg8::MoeOrder S{tb, 8, F.G, (int)blockIdx.x};
        pg8::EpiFp8 E{Y8, DM, in[25], DM};
        pg8::gemm_phase<pg8::EpiFp8, pg8::MoeOrder, true, true, true>(F.lds + RING_OFF, g, S, E);
        GRID_BAR();
    }

    if (IN(10)) {
        moe_tables(F);
        for (int m = gw; m < T; m += NGW) {
            f32x4 v[8];
#pragma unroll
            for (int j = 0; j < 8; ++j) { const v2u w = *(const v2u*)(H1 + (size_t)m * DM + 4 * (F.lane + 64 * j)); v[j] = (f32x4){bflo(w.x), bfhi(w.x), bflo(w.y), bfhi(w.y)}; }
#pragma unroll
            for (int k = 0; k < 4; ++k) { const int ek = TOKE[m * 4 + k], pk = TOKP[m * 4 + k]; const float gk = TOKG[m * 4 + k]; const unsigned char* y = Y8 + ((size_t)tb[ek] * 256 + pk) * DM;
#pragma unroll
                for (int j = 0; j < 8; ++j) { const unsigned w = *(const unsigned*)(y + 4 * (F.lane + 64 * j));
                    const f32x2 lo = __builtin_amdgcn_cvt_pk_f32_fp8((int)w, false), hi2 = __builtin_amdgcn_cvt_pk_f32_fp8((int)w, true);
                    v[j].x += gk * lo[0]; v[j].y += gk * lo[1]; v[j].z += gk * hi2[0]; v[j].w += gk * hi2[1]; } }
            float s = 0.f;
#pragma unroll
            for (int j = 0; j < 8; ++j) s += (v[j].x * v[j].x + v[j].y * v[j].y) + (v[j].z * v[j].z + v[j].w * v[j].w);
            const float r = 1.0f / sqrtf(wave_sum(s) * (1.0f / DM) + EPS);
#pragma unroll
            for (int j = 0; j < 8; ++j) { const int col = 4 * (F.lane + 64 * j); const f32x4 g = *(const f32x4*)(in[26] + col);
                *(f32x4*)(args.out + (size_t)m * DM + col) = (f32x4){v[j].x * r * g.x, v[j].y * r * g.y, v[j].z * r * g.z, v[j].w * r * g.w}; }
        }
    }
#undef IN
#undef GRID_BAR
}

extern "C" void kernel_launch(void* const* d_in, const int* in_sizes, int n_in, void* d_out, int out_size, void* d_ws, size_t ws_size, hipStream_t stream) {
    static int grid = 0;
    if (grid == 0) {
        if (n_in != 27 || in_sizes[0] != T * DM || out_size != T * DM || ws_size < WS_END) {
            fprintf(stderr, "kernel_launch: shape/workspace mismatch: n_in %d in0 %d out %d ws %zu (need %zu); nothing launched\n", n_in, n_in > 0 ? in_sizes[0] : -1, out_size, ws_size, (size_t)WS_END); grid = -1; return; }
        int dev = 0, cus = 0, per_cu = 0;
        if (hipGetDevice(&dev) != hipSuccess || hipDeviceGetAttribute(&cus, hipDeviceAttributeMultiprocessorCount, dev) != hipSuccess) { fprintf(stderr, "kernel_launch: device query failed\n"); grid = -1; return; }
        if (hipFuncSetAttribute((const void*)mk_fwd, hipFuncAttributeMaxDynamicSharedMemorySize, LDS_BYTES) != hipSuccess) { fprintf(stderr, "kernel_launch: hipFuncSetAttribute failed\n"); grid = -1; return; }
        if (hipOccupancyMaxActiveBlocksPerMultiprocessor(&per_cu, (const void*)mk_fwd, NWAVES * 64, LDS_BYTES) != hipSuccess || per_cu < 1)
            fprintf(stderr, "kernel_launch: note: occupancy query reports %d workgroups per CU\n", per_cu);
        (void)hipGetLastError();
        grid = cus;
    }
    if (grid < 0) return;
    if (hipMemsetAsync((char*)d_ws + WS_CTL, 0, CTL_ZERO_BYTES, stream) != hipSuccess) { fprintf(stderr, "kernel_launch: memset failed\n"); return; }
    Args a{};
    for (int i = 0; i < 27; ++i) a.in[i] = (const float*)d_in[i];
    a.out = (float*)d_out; a.ws = (unsigned char*)d_ws; a.pad = 0;
    for (int li = 0; li < N_LAUNCHES; ++li) {
        a.ph_lo = (N_LAUNCHES == 1) ? 0 : li; a.ph_hi = (N_LAUNCHES == 1) ? NPH : li + 1; a.li = li;
        hipLaunchKernelGGL(mk_fwd, dim3(grid), dim3(NWAVES * 64), LDS_BYTES, stream, a);
        const hipError_t le = hipPeekAtLastError();
        if (le != hipSuccess) { fprintf(stderr, "kernel_launch: launch %d failed: %s\n", li, hipGetErrorName(le)); break; }
    }
}
```
